# Optimizing an MI355X kernel written in HIP

```python
import jax
import jax.numpy as jnp
from jax import lax
import numpy as np


D_MODEL = 1024
BATCH = 1
SEQ = 16384
DEPTH = 4

N_HEADS = 16
HEAD_DIM = D_MODEL // N_HEADS
ROPE_DIM = HEAD_DIM // 4
ROPE_THETA = 500000.0
NSA_KV_HEADS = 4
NSA_GROUP = N_HEADS // NSA_KV_HEADS
CMP_BLOCK = 32
CMP_STRIDE = 16
CMP_HIDDEN = 256
SEL_BLOCK = 64
SEL_TOPK = 16
WINDOW = 512
NSA_Q_CHUNK = 128
NSA_Q_DIM = N_HEADS * HEAD_DIM
NSA_KV_DIM = NSA_KV_HEADS * HEAD_DIM
NSA_IN = NSA_Q_DIM + 6 * NSA_KV_DIM + 3 * N_HEADS
MOBA_BLOCK = 256
MOBA_TOPK = 3
MOBA_Q_CHUNK = 64
D_FF = -(-8 * D_MODEL // (3 * 256)) * 256
ALPHA = (2 * DEPTH) ** 0.25
BETA = (8 * DEPTH) ** -0.25
N_NSA = (DEPTH + 1) // 2
N_MOBA = DEPTH // 2
LN_EPS = 1e-5
LARGE = 1e30

kernel_name = 'hybrid_nsa_moba_deepnorm'


def rope_partial(x, pos):
    inv = ROPE_THETA ** (-jnp.arange(0, ROPE_DIM, 2, dtype=jnp.float32) / ROPE_DIM)
    ang = pos.astype(jnp.float32)[..., None] * inv
    cos = jnp.cos(ang)[:, :, None, :]
    sin = jnp.sin(ang)[:, :, None, :]
    xr = x[..., :ROPE_DIM].astype(jnp.float32)
    x1, x2 = xr[..., :ROPE_DIM // 2], xr[..., ROPE_DIM // 2:]
    rot = jnp.concatenate([x1 * cos - x2 * sin, x2 * cos + x1 * sin], axis=-1).astype(x.dtype)
    return jnp.concatenate([rot, x[..., ROPE_DIM:]], axis=-1)


def masked_softmax(s, mask):
    return jax.nn.softmax(jnp.where(mask, s, -LARGE), axis=-1)


def layer_norm(x, g, b):
    xf = x.astype(jnp.float32)
    mu = jnp.mean(xf, axis=-1, keepdims=True)
    var = jnp.mean(jnp.square(xf - mu), axis=-1, keepdims=True)
    y = (xf - mu) * lax.rsqrt(var + LN_EPS)
    return (y * g + b).astype(x.dtype)


def compress(k, pos_emb, w1, w2):
    B, S, G, hd = k.shape
    n_cmp = (S - CMP_BLOCK) // CMP_STRIDE + 1
    idx = jnp.arange(n_cmp)[:, None] * CMP_STRIDE + jnp.arange(CMP_BLOCK)[None, :]
    blocks = k[:, idx] + pos_emb[None, None, :, None, :]
    blocks = blocks.transpose(0, 3, 1, 2, 4).reshape(B, G, n_cmp, CMP_BLOCK * hd)
    return jax.nn.gelu(blocks @ w1) @ w2


def nsa_mixer(h, pos, w_in, w_o, ck_pos, ck_w1, ck_w2, cv_pos, cv_w1, cv_w2):
    B, S, _ = h.shape
    G, R, hd, CH = NSA_KV_HEADS, NSA_GROUP, HEAD_DIM, NSA_Q_CHUNK
    proj = h @ w_in
    q = rope_partial(proj[..., :NSA_Q_DIM].reshape(B, S, N_HEADS, hd), pos).reshape(B, S, G, R, hd)
    kv = proj[..., NSA_Q_DIM:NSA_Q_DIM + 6 * NSA_KV_DIM].reshape(B, S, 6, G, hd)
    gates = jax.nn.sigmoid(proj[..., NSA_Q_DIM + 6 * NSA_KV_DIM:].astype(jnp.float32)).reshape(B, S, G, R, 3)
    k_cmp = rope_partial(kv[:, :, 0], pos)
    v_cmp = kv[:, :, 1]
    k_sel = rope_partial(kv[:, :, 2], pos)
    v_sel = kv[:, :, 3]
    k_win = rope_partial(kv[:, :, 4], pos)
    v_win = kv[:, :, 5]

    kc = compress(k_cmp, ck_pos, ck_w1, ck_w2)
    vc = compress(v_cmp, cv_pos, cv_w1, cv_w2)
    n_cmp = kc.shape[2]
    cmp_start = jnp.arange(n_cmp) * CMP_STRIDE
    cmp_end = cmp_start + CMP_BLOCK - 1
    n_sel = S // SEL_BLOCK
    n_top = min(SEL_TOPK, n_sel)
    sel_ids = jnp.arange(n_sel)
    sel_start = sel_ids * SEL_BLOCK
    lo = jnp.maximum(cmp_start[:, None], sel_start[None, :])
    hi = jnp.minimum(cmp_end[:, None], sel_start[None, :] + SEL_BLOCK - 1)
    overlap = jnp.clip(hi - lo + 1, 0, None).astype(jnp.float32) / CMP_STRIDE

    ks_blk = k_sel.reshape(B, n_sel, SEL_BLOCK, G, hd).transpose(0, 3, 1, 2, 4)
    vs_blk = v_sel.reshape(B, n_sel, SEL_BLOCK, G, hd).transpose(0, 3, 1, 2, 4)
    kw_pad = jnp.pad(k_win, ((0, 0), (WINDOW, 0), (0, 0), (0, 0)))
    vw_pad = jnp.pad(v_win, ((0, 0), (WINDOW, 0), (0, 0), (0, 0)))
    scale = HEAD_DIM ** -0.5
    b_ix = jnp.arange(B)[:, None, None, None]
    g_ix = jnp.arange(G)[None, :, None, None]

    def step(c):
        qs = c * CH
        tq = qs + jnp.arange(CH)
        qc = lax.dynamic_slice_in_dim(q, qs, CH, axis=1)
        gc = lax.dynamic_slice_in_dim(gates, qs, CH, axis=1)
        s = jnp.einsum('bqgrd,bgnd->bgrqn', qc, kc).astype(jnp.float32) * scale
        m = cmp_end[None, :] <= tq[:, None]
        p_cmp = masked_softmax(s, m) * jnp.any(m, axis=-1)[:, None]
        o_cmp = jnp.einsum('bgrqn,bgnd->bqgrd', p_cmp.astype(vc.dtype), vc)
        imp = jnp.einsum('bgrqn,nj->bgqj', p_cmp, overlap)
        blk = tq // SEL_BLOCK
        causal = sel_start[None, :] <= tq[:, None]
        forced = (sel_ids[None, :] == 0) | (sel_ids[None, :] == blk[:, None]) | (sel_ids[None, :] == blk[:, None] - 1)
        score = jnp.where(forced, LARGE, jnp.where(causal, imp, -LARGE))
        _, sel = lax.top_k(score, n_top)
        kg = ks_blk[b_ix, g_ix, sel].reshape(B, G, CH, n_top * SEL_BLOCK, hd)
        vg = vs_blk[b_ix, g_ix, sel].reshape(B, G, CH, n_top * SEL_BLOCK, hd)
        kpos = sel[..., None] * SEL_BLOCK + jnp.arange(SEL_BLOCK)
        msel = (kpos <= tq[:, None, None]).reshape(B, G, 1, CH, n_top * SEL_BLOCK)
        s = jnp.einsum('bqgrd,bgqkd->bgrqk', qc, kg).astype(jnp.float32) * scale
        p = masked_softmax(s, msel)
        o_sel = jnp.einsum('bgrqk,bgqkd->bqgrd', p.astype(vg.dtype), vg)
        kwc = lax.dynamic_slice_in_dim(kw_pad, qs, CH + WINDOW, axis=1)
        vwc = lax.dynamic_slice_in_dim(vw_pad, qs, CH + WINDOW, axis=1)
        kpos_w = qs - WINDOW + jnp.arange(CH + WINDOW)
        dist = tq[:, None] - kpos_w[None, :]
        mw = (kpos_w[None, :] >= 0) & (dist >= 0) & (dist < WINDOW)
        s = jnp.einsum('bqgrd,bkgd->bgrqk', qc, kwc).astype(jnp.float32) * scale
        p = masked_softmax(s, mw)
        o_win = jnp.einsum('bgrqk,bkgd->bqgrd', p.astype(vwc.dtype), vwc)
        o = gc[..., 0:1] * o_cmp + gc[..., 1:2] * o_sel + gc[..., 2:3] * o_win
        return o.reshape(B, CH, NSA_Q_DIM).astype(h.dtype)

    out = lax.map(step, jnp.arange(S // CH))
    out = out.transpose(1, 0, 2, 3).reshape(B, S, NSA_Q_DIM)
    return out @ w_o


def moba_mixer(h, pos, w_in, w_o):
    B, S, _ = h.shape
    H, hd, CH, BLK = N_HEADS, HEAD_DIM, MOBA_Q_CHUNK, MOBA_BLOCK
    proj = h @ w_in
    q = rope_partial(proj[..., :D_MODEL].reshape(B, S, H, hd), pos)
    k = rope_partial(proj[..., D_MODEL:2 * D_MODEL].reshape(B, S, H, hd), pos)
    v = proj[..., 2 * D_MODEL:].reshape(B, S, H, hd)
    n_blk = -(-S // BLK)
    pad = n_blk * BLK - S
    kb = jnp.pad(k, ((0, 0), (0, pad), (0, 0), (0, 0))).reshape(B, n_blk, BLK, H, hd).transpose(0, 3, 1, 2, 4)
    vb = jnp.pad(v, ((0, 0), (0, pad), (0, 0), (0, 0))).reshape(B, n_blk, BLK, H, hd).transpose(0, 3, 1, 2, 4)
    kmean = jnp.mean(kb.astype(jnp.float32), axis=3)
    k_eff = min(MOBA_TOPK, max(n_blk - 1, 1))
    scale = HEAD_DIM ** -0.5
    b_ix = jnp.arange(B)[:, None, None, None]
    h_ix = jnp.arange(H)[None, :, None, None]
    blk_ids = jnp.arange(n_blk)

    def step(c):
        qs = c * CH
        tq = qs + jnp.arange(CH)
        cur = qs // BLK
        qc = lax.dynamic_slice_in_dim(q, qs, CH, axis=1)
        gate = jnp.einsum('bqhd,bhnd->bhqn', qc.astype(jnp.float32), kmean)
        gate = jnp.where(blk_ids < cur, gate, -LARGE)
        _, sel = lax.top_k(gate, k_eff)
        valid = sel < cur
        kg = kb[b_ix, h_ix, sel].reshape(B, H, CH, k_eff * BLK, hd)
        vg = vb[b_ix, h_ix, sel].reshape(B, H, CH, k_eff * BLK, hd)
        msel = jnp.broadcast_to(valid[..., None], valid.shape + (BLK,)).reshape(B, H, CH, k_eff * BLK)
        k_own = lax.dynamic_index_in_dim(kb, cur, axis=2, keepdims=False)
        v_own = lax.dynamic_index_in_dim(vb, cur, axis=2, keepdims=False)
        own_pos = cur * BLK + jnp.arange(BLK)
        mown = jnp.broadcast_to(own_pos[None, :] <= tq[:, None], (B, H, CH, BLK))
        s_sel = jnp.einsum('bqhd,bhqkd->bhqk', qc, kg).astype(jnp.float32) * scale
        s_own = jnp.einsum('bqhd,bhkd->bhqk', qc, k_own).astype(jnp.float32) * scale
        p = masked_softmax(jnp.concatenate([s_sel, s_own], axis=-1), jnp.concatenate([msel, mown], axis=-1))
        p = p.astype(vg.dtype)
        o = (jnp.einsum('bhqk,bhqkd->bqhd', p[..., :k_eff * BLK], vg)
             + jnp.einsum('bhqk,bhkd->bqhd', p[..., k_eff * BLK:], v_own))
        return o.reshape(B, CH, D_MODEL).astype(h.dtype)

    out = lax.map(step, jnp.arange(S // CH))
    out = out.transpose(1, 0, 2, 3).reshape(B, S, D_MODEL)
    return out @ w_o


def swiglu(h, wg, wu, wd):
    return (jax.nn.silu(h @ wg) * (h @ wu)) @ wd


def setup_inputs(seed: int = 0) -> dict:
    key = jax.random.key(seed)
    ks = jax.random.split(key, 20)

    def nrm(k, shape, s):
        return jax.random.normal(k, shape, jnp.float32) * s

    x = nrm(ks[0], (BATCH, SEQ, D_MODEL), 1.0)
    positions = jnp.broadcast_to(jnp.arange(SEQ, dtype=jnp.int32)[None, :], (BATCH, SEQ))
    nsa_col = np.ones((NSA_IN,), np.float32)
    for m in (1, 3, 5):
        s0 = NSA_Q_DIM + m * NSA_KV_DIM
        nsa_col[s0:s0 + NSA_KV_DIM] = BETA
    nsa_w_in = nrm(ks[1], (N_NSA, D_MODEL, NSA_IN), D_MODEL ** -0.5) * jnp.asarray(nsa_col)
    nsa_w_o = nrm(ks[2], (N_NSA, NSA_Q_DIM, D_MODEL), BETA * NSA_Q_DIM ** -0.5)
    nsa_ck_pos = nrm(ks[3], (N_NSA, CMP_BLOCK, HEAD_DIM), 0.02)
    nsa_ck_w1 = nrm(ks[4], (N_NSA, CMP_BLOCK * HEAD_DIM, CMP_HIDDEN), (CMP_BLOCK * HEAD_DIM) ** -0.5)
    nsa_ck_w2 = nrm(ks[5], (N_NSA, CMP_HIDDEN, HEAD_DIM), CMP_HIDDEN ** -0.5)
    nsa_cv_pos = nrm(ks[6], (N_NSA, CMP_BLOCK, HEAD_DIM), 0.02)
    nsa_cv_w1 = nrm(ks[7], (N_NSA, CMP_BLOCK * HEAD_DIM, CMP_HIDDEN), (CMP_BLOCK * HEAD_DIM) ** -0.5)
    nsa_cv_w2 = nrm(ks[8], (N_NSA, CMP_HIDDEN, HEAD_DIM), CMP_HIDDEN ** -0.5)
    moba_col = np.ones((3 * D_MODEL,), np.float32)
    moba_col[2 * D_MODEL:] = BETA
    moba_w_in = nrm(ks[9], (N_MOBA, D_MODEL, 3 * D_MODEL), D_MODEL ** -0.5) * jnp.asarray(moba_col)
    moba_w_o = nrm(ks[10], (N_MOBA, D_MODEL, D_MODEL), BETA * D_MODEL ** -0.5)
    ffn_wg = nrm(ks[11], (DEPTH, D_MODEL, D_FF), D_MODEL ** -0.5)
    ffn_wu = nrm(ks[12], (DEPTH, D_MODEL, D_FF), D_MODEL ** -0.5)
    ffn_wd = nrm(ks[13], (DEPTH, D_FF, D_MODEL), BETA * D_FF ** -0.5)
    ln1_g = 1.0 + nrm(ks[14], (DEPTH, D_MODEL), 0.02)
    ln1_b = nrm(ks[15], (DEPTH, D_MODEL), 0.02)
    ln2_g = 1.0 + nrm(ks[16], (DEPTH, D_MODEL), 0.02)
    ln2_b = nrm(ks[17], (DEPTH, D_MODEL), 0.02)
    return {'x': x, 'positions': positions,
            'nsa_w_in': nsa_w_in, 'nsa_w_o': nsa_w_o,
            'nsa_ck_pos': nsa_ck_pos, 'nsa_ck_w1': nsa_ck_w1, 'nsa_ck_w2': nsa_ck_w2,
            'nsa_cv_pos': nsa_cv_pos, 'nsa_cv_w1': nsa_cv_w1, 'nsa_cv_w2': nsa_cv_w2,
            'moba_w_in': moba_w_in, 'moba_w_o': moba_w_o,
            'ffn_wg': ffn_wg, 'ffn_wu': ffn_wu, 'ffn_wd': ffn_wd,
            'ln1_g': ln1_g, 'ln1_b': ln1_b, 'ln2_g': ln2_g, 'ln2_b': ln2_b}


def reference(x, positions, nsa_w_in, nsa_w_o, nsa_ck_pos, nsa_ck_w1, nsa_ck_w2,
              nsa_cv_pos, nsa_cv_w1, nsa_cv_w2, moba_w_in, moba_w_o,
              ffn_wg, ffn_wu, ffn_wd, ln1_g, ln1_b, ln2_g, ln2_b):
    for i in range(DEPTH):
        j = i // 2
        if i % 2 == 0:
            a = nsa_mixer(x, positions, nsa_w_in[j], nsa_w_o[j], nsa_ck_pos[j], nsa_ck_w1[j],
                          nsa_ck_w2[j], nsa_cv_pos[j], nsa_cv_w1[j], nsa_cv_w2[j])
        else:
            a = moba_mixer(x, positions, moba_w_in[j], moba_w_o[j])
        x = layer_norm(ALPHA * x + a, ln1_g[i], ln1_b[i])
        f = swiglu(x, ffn_wg[i], ffn_wu[i], ffn_wd[i])
        x = layer_norm(ALPHA * x + f, ln2_g[i], ln2_b[i])
    return x
```

```cpp
#include <hip/hip_runtime.h>
#include <hip/hip_cooperative_groups.h>
#include <cstdio>
#include <cstdint>
namespace cg = cooperative_groups;
namespace pg8 {
#define PG8_LAS __attribute__((address_space(3)))
typedef unsigned short bf16_t;
typedef short bf16x8 __attribute__((ext_vector_type(8)));
typedef float f32x4 __attribute__((ext_vector_type(4)));
typedef unsigned u32x4 __attribute__((ext_vector_type(4)));
constexpr int BM = 256, BK = 64, HALF = 128, HTB = HALF * BK * 2  , STAGE_BYTES = 8 * HTB, NXCD = 8, WGM = 8;

__host__ __device__ __forceinline__ int lds_byte(int r, int c) { const int st = (r >> 4) * 2 + (c >> 5), rr = r & 15, cc = c & 31, ob = rr * 64 + cc * 2; return st * 1024 + (ob ^ (((ob >> 9) & 1) << 5)); }
__host__ __device__ __forceinline__ void stage_rc(int b, int& R, int& C) { const int st = b / 1024, sb = b % 1024, swz = sb ^ (((sb >> 9) & 1) << 5); R = (st >> 1) * 16 + swz / 64; C = (st & 1) * 32 + (swz % 64) / 2; }
__host__ __device__ __forceinline__ int perm32(int rho) { const int n = rho >> 4, i = rho & 15; return 8 * (i >> 2) + 4 * n + (i & 3); }

struct Unit { int pm, pn; };
struct Gemm { const bf16_t* A; const bf16_t* Bt; int M, N, K, lda; };

struct StaticOrder {
    int nM, nN, nwg, G, c;
    __host__ __device__ void init(int M, int N, int G_, int c_) { nM = M / BM; nN = N / BM; nwg = nM * nN; G = G_; c = c_; }
    __host__ __device__ bool next(int i, Unit& u) const {
        const long L = (long)i * G + c; if (L >= nwg) return false;
        int wgid = (int)L; { const int q = nwg / NXCD, r = nwg % NXCD, xcd = wgid % NXCD, off = wgid / NXCD; wgid = (xcd < r ? xcd * (q + 1) : r * (q + 1) + (xcd - r) * q) + off; }
        const int nig = WGM * nN, gid = wgid / nig, fm = gid * WGM, gsz = (nM - fm) < WGM ? (nM - fm) : WGM;
        u.pm = fm + ((wgid % nig) % gsz); u.pn = (wgid % nig) / gsz; return true;
    }
    __device__ __forceinline__ void a_ready(const Unit&) const {}
    __device__ __forceinline__ void done(const Unit&) const {}
};

__device__ __forceinline__ unsigned cvt_pk_bf16(float lo, float hi) { unsigned r; asm volatile("v_cvt_pk_bf16_f32 %0, %1, %2" : "=v"(r) : "v"(lo), "v"(hi)); return r; }
typedef float f32x2 __attribute__((ext_vector_type(2)));
__device__ __forceinline__ f32x2 gelu_pk(f32x2 v) {
    const f32x2 av = __builtin_elementwise_abs(v), d = av * 0.2316418882f + 1.0f;
    f32x2 t; t.x = __builtin_amdgcn_rcpf(d.x); t.y = __builtin_amdgcn_rcpf(d.y);
    f32x2 q = t * 0.5307027145f + (-0.7265760135f); q = q * t + 0.7107068705f; q = q * t + (-0.142248368f); q = q * t + 0.127414796f; q = q * t;
    const f32x2 s = (v * v) * (-0.72134752044f);
    f32x2 e; e.x = __builtin_amdgcn_exp2f(s.x); e.y = __builtin_amdgcn_exp2f(s.y);
    const f32x2 m = v * (q * e), r = v - m;
    f32x2 o; o.x = v.x < 0.f ? m.x : r.x; o.y = v.y < 0.f ? m.y : r.y; return o;
}

template <int ACT  > struct EpiBf16 {
    static constexpr bool PERM = true, AFTER_DRAIN = false; static_assert(ACT == 0 || ACT == 1, "EpiBf16: ACT is 0 (none) or 1 (gelu_pk)");
    bf16_t* O; int ldc; const float* bias; int split_cols; size_t split_stride; float scale0;
    __device__ __forceinline__ void operator()(const f32x4 (&acc)[2][2][4][2], const Unit& u, int wr, int wc, int fr, int fq) const {
        const int row0 = u.pm * BM + wr * 64 + fr; int colt = u.pn * BM; bf16_t* base = O;
        float sc = 1.f; if (split_cols) { const int t = colt / split_cols; base += (size_t)t * split_stride; colt -= t * split_cols; if (t == 0) sc = scale0; }
        const int col0 = colt + wc * 32 + 8 * fq, bcol0 = u.pn * BM + wc * 32 + 8 * fq;
        f32x4 bv[2][2];
#pragma unroll
        for (int bj = 0; bj < 2; ++bj)
#pragma unroll
            for (int n = 0; n < 2; ++n) bv[bj][n] = bias ? *(const f32x4*)(bias + bcol0 + bj * HALF + 4 * n) : (f32x4){0.f, 0.f, 0.f, 0.f};
#pragma unroll
        for (int ai = 0; ai < 2; ++ai)
#pragma unroll
            for (int m = 0; m < 4; ++m) { bf16_t* rowp = base + (size_t)(row0 + ai * HALF + m * 16) * ldc + col0;
#pragma unroll
                for (int bj = 0; bj < 2; ++bj) { f32x4 v0 = acc[ai][bj][m][0] + bv[bj][0], v1 = acc[ai][bj][m][1] + bv[bj][1];
                    if (ACT == 1) { f32x2 a = gelu_pk((f32x2){v0[0], v0[1]}), b = gelu_pk((f32x2){v0[2], v0[3]}), c = gelu_pk((f32x2){v1[0], v1[1]}), d = gelu_pk((f32x2){v1[2], v1[3]});
                        v0 = (f32x4){a.x, a.y, b.x, b.y}; v1 = (f32x4){c.x, c.y, d.x, d.y}; }
                    v0 = v0 * sc; v1 = v1 * sc; u32x4 w; w.x = cvt_pk_bf16(v0[0], v0[1]); w.y = cvt_pk_bf16(v0[2], v0[3]); w.z = cvt_pk_bf16(v1[0], v1[1]); w.w = cvt_pk_bf16(v1[2], v1[3]);
                    *(u32x4*)(rowp + bj * HALF) = w; } }
    }
};
template <class Epi, class Sched, bool ALIGN_EPI = false, bool SP2 = false>
__device__ __forceinline__ void gemm_phase(PG8_LAS unsigned char* lds, const Gemm g, const Sched& S, const Epi& E) {
    int tid_l = threadIdx.x; asm volatile("" : "+v"(tid_l)); const int tid = tid_l, wid = __builtin_amdgcn_readfirstlane(tid >> 6), lane = tid & 63, wr = wid >> 2, wc = wid & 3, fr = lane & 15, fq = lane >> 4;
    const int K = g.K, nt = K / BK;
    unsigned voffA[2], voffB[2];
#pragma unroll
    for (int i = 0; i < 2; ++i) { int R, C; stage_rc(tid * 16 + i * 8192, R, C); const int Rb = Epi::PERM ? ((R & ~31) + perm32(R & 31)) : R;
        voffA[i] = (unsigned)(R * g.lda + C) * 2u; voffB[i] = (unsigned)(Rb * K + C) * 2u; }
    const size_t kstep = (size_t)(BK * 2);
    const size_t hstepB = (size_t)HALF * K * 2, hstepA = (size_t)HALF * g.lda * 2;
    const size_t tstepB = 2 * hstepB, tstepA = 2 * hstepA;
    const unsigned ldsw = (unsigned)wid * 1024u;
    const int aoff = lds_byte(wr * 64 + fr, fq * 8), boff = lds_byte(wc * 32 + fr, fq * 8);
#define PG8_SA(b, h) (((b) * 2 + (h)) * HTB)
#define PG8_SB(b, h) ((4 + (b) * 2 + (h)) * HTB)
#define PG8_STAGE(bufoff, gbase, voff) do { _Pragma("unroll") for (int _i = 0; _i < 2; ++_i) \
        __builtin_amdgcn_global_load_lds((const unsigned*)((const char*)(gbase) + (voff)[_i]), (PG8_LAS unsigned*)(lds + (bufoff) + ldsw + _i * 8192), 16, 0, 0); } while (0)
#define PG8_LDA(dst, b, h) do { _Pragma("unroll") for (int m = 0; m < 4; ++m) _Pragma("unroll") for (int k = 0; k < 2; ++k) dst[m][k] = *(const PG8_LAS bf16x8*)(lds + PG8_SA(b, h) + aoff + m * 2048 + k * 1024); } while (0)
#define PG8_LDB(dst, b, h) do { _Pragma("unroll") for (int n = 0; n < 2; ++n) _Pragma("unroll") for (int k = 0; k < 2; ++k) dst[n][k] = *(const PG8_LAS bf16x8*)(lds + PG8_SB(b, h) + boff + n * 2048 + k * 1024); } while (0)
#define PG8_MMA(ai, bj, At, Bt) do { __builtin_amdgcn_s_setprio(1); _Pragma("unroll") for (int m = 0; m < 4; ++m) _Pragma("unroll") for (int n = 0; n < 2; ++n) _Pragma("unroll") for (int k = 0; k < 2; ++k) \
        acc[ai][bj][m][n] = __builtin_amdgcn_mfma_f32_16x16x32_bf16(Bt[n][k], At[m][k], acc[ai][bj][m][n], 0, 0, 0); __builtin_amdgcn_s_setprio(0); } while (0)
#define PG8_WAIT_V(n) asm volatile("s_waitcnt vmcnt(" #n ")" ::: "memory")
#define PG8_WAIT_L(n) asm volatile("s_waitcnt lgkmcnt(" #n ")" ::: "memory")
#define PG8_BAR __builtin_amdgcn_s_barrier()
#define PG8_SCHED __builtin_amdgcn_sched_barrier(0)
    Unit cur, nxt; int ui = 0;
    if (!S.next(0, cur)) return;
    f32x4 acc[2][2][4][2];
#pragma unroll
    for (int a = 0; a < 2; ++a)
#pragma unroll
        for (int b = 0; b < 2; ++b)
#pragma unroll
            for (int m = 0; m < 4; ++m)
#pragma unroll
                for (int n = 0; n < 2; ++n) acc[a][b][m][n] = (f32x4){0.f, 0.f, 0.f, 0.f};
    bf16x8 At[4][2], B0[2][2], B1[2][2];
    const char* cA = (const char*)g.A + (size_t)cur.pm * tstepA; const char* cB = (const char*)g.Bt + (size_t)cur.pn * tstepB;
    S.a_ready(cur);
    if constexpr (SP2) {
        PG8_STAGE(PG8_SB(0, 0), cB, voffB); PG8_STAGE(PG8_SB(0, 1), cB + hstepB, voffB); PG8_STAGE(PG8_SA(0, 0), cA, voffA); PG8_STAGE(PG8_SA(0, 1), cA + hstepA, voffA);
        if (wr == 1) PG8_BAR;
        PG8_WAIT_V(2); PG8_BAR;
        PG8_STAGE(PG8_SB(1, 0), cB + kstep, voffB); PG8_STAGE(PG8_SA(1, 0), cA + kstep, voffA); PG8_STAGE(PG8_SB(1, 1), cB + hstepB + kstep, voffB);
        PG8_WAIT_V(6); PG8_BAR;
    } else {
        PG8_STAGE(PG8_SB(0, 0), cB, voffB); PG8_STAGE(PG8_SA(0, 0), cA, voffA); PG8_STAGE(PG8_SB(0, 1), cB + hstepB, voffB); PG8_STAGE(PG8_SA(0, 1), cA + hstepA, voffA);
        if (wr == 1) PG8_BAR;
        PG8_WAIT_V(4); PG8_BAR;
        PG8_STAGE(PG8_SB(1, 0), cB + kstep, voffB); PG8_STAGE(PG8_SA(1, 0), cA + kstep, voffA); PG8_STAGE(PG8_SB(1, 1), cB + hstepB + kstep, voffB);
        PG8_WAIT_V(6); PG8_BAR;
    }
    for (;;) {
        const bool has_next = S.next(ui + 1, nxt);
        const char* nA = has_next ? (const char*)g.A + (size_t)nxt.pm * tstepA : cA; const char* nB = has_next ? (const char*)g.Bt + (size_t)nxt.pn * tstepB : cB;
        for (int t = 0; t < nt; t += 2) {
            const bool last = (t == nt - 2);
            const char* a1 = cA + (size_t)(t + 1) * kstep;
            const char* a2 = last ? nA : cA + (size_t)(t + 2) * kstep; const char* b2 = last ? nB : cB + (size_t)(t + 2) * kstep;
            const char* a3 = a2 + kstep; const char* b3 = b2 + kstep;
            if (last && has_next) S.a_ready(nxt);
            if constexpr (SP2) {
            PG8_LDB(B0, 0, 0); PG8_LDB(B1, 0, 1); PG8_SCHED; PG8_LDA(At, 0, 0); PG8_STAGE(PG8_SA(1, 1), a1 + hstepA, voffA);
            PG8_WAIT_V(8); PG8_WAIT_L(0); PG8_BAR; PG8_MMA(0, 0, At, B0); PG8_MMA(0, 1, At, B1); PG8_BAR; PG8_SCHED;
            PG8_LDA(At, 0, 1); PG8_STAGE(PG8_SB(0, 0), b2, voffB); PG8_STAGE(PG8_SB(0, 1), b2 + hstepB, voffB); PG8_STAGE(PG8_SA(0, 0), a2, voffA);
            PG8_WAIT_V(8); PG8_WAIT_L(0); PG8_BAR; PG8_MMA(1, 0, At, B0); PG8_MMA(1, 1, At, B1); PG8_BAR; PG8_SCHED;
            PG8_LDB(B0, 1, 0); PG8_LDB(B1, 1, 1); PG8_SCHED; PG8_LDA(At, 1, 0); PG8_STAGE(PG8_SA(0, 1), a2 + hstepA, voffA);
            PG8_WAIT_V(8); PG8_WAIT_L(0); PG8_BAR; PG8_MMA(0, 0, At, B0); PG8_MMA(0, 1, At, B1); PG8_BAR; PG8_SCHED;
            PG8_LDA(At, 1, 1); PG8_STAGE(PG8_SB(1, 0), b3, voffB); PG8_STAGE(PG8_SB(1, 1), b3 + hstepB, voffB); PG8_STAGE(PG8_SA(1, 0), a3, voffA);
            PG8_WAIT_V(8); PG8_WAIT_L(0); PG8_BAR; PG8_MMA(1, 0, At, B0); PG8_MMA(1, 1, At, B1); PG8_BAR; PG8_SCHED;
            } else {
            PG8_LDB(B0, 0, 0); PG8_SCHED; PG8_LDA(At, 0, 0); PG8_STAGE(PG8_SA(1, 1), a1 + hstepA, voffA);
            PG8_WAIT_L(8); PG8_BAR; PG8_WAIT_L(0); PG8_MMA(0, 0, At, B0); PG8_BAR; PG8_SCHED;
            PG8_LDB(B1, 0, 1); PG8_STAGE(PG8_SB(0, 0), b2, voffB);
            PG8_BAR; PG8_WAIT_L(0); PG8_MMA(0, 1, At, B1); PG8_BAR;
            PG8_LDA(At, 0, 1); PG8_STAGE(PG8_SA(0, 0), a2, voffA);
            PG8_BAR; PG8_WAIT_L(0); PG8_MMA(1, 0, At, B0); PG8_BAR; PG8_SCHED;
            PG8_STAGE(PG8_SB(0, 1), b2 + hstepB, voffB);
            PG8_WAIT_V(6); PG8_BAR; PG8_MMA(1, 1, At, B1); PG8_BAR;
            PG8_LDB(B0, 1, 0); PG8_SCHED; PG8_LDA(At, 1, 0); PG8_STAGE(PG8_SA(0, 1), a2 + hstepA, voffA);
            PG8_WAIT_L(8); PG8_BAR; PG8_WAIT_L(0); PG8_MMA(0, 0, At, B0); PG8_BAR; PG8_SCHED;
            PG8_LDB(B1, 1, 1); PG8_STAGE(PG8_SB(1, 0), b3, voffB);
            PG8_BAR; PG8_WAIT_L(0); PG8_MMA(0, 1, At, B1); PG8_BAR;
            PG8_LDA(At, 1, 1); PG8_STAGE(PG8_SA(1, 0), a3, voffA);
            PG8_BAR; PG8_WAIT_L(0); PG8_MMA(1, 0, At, B0); PG8_BAR; PG8_SCHED;
            PG8_STAGE(PG8_SB(1, 1), b3 + hstepB, voffB);
            PG8_WAIT_V(6); PG8_BAR; PG8_MMA(1, 1, At, B1); PG8_BAR;
            }
        }
        if constexpr (ALIGN_EPI) { if (wr == 0) PG8_BAR; }
        if constexpr (!Epi::AFTER_DRAIN) { E(acc, cur, wr, wc, fr, fq); S.done(cur); }
        if (!has_next) break;
#pragma unroll
        for (int a = 0; a < 2; ++a)
#pragma unroll
            for (int b = 0; b < 2; ++b)
#pragma unroll
                for (int m = 0; m < 4; ++m)
#pragma unroll
                    for (int n = 0; n < 2; ++n) acc[a][b][m][n] = (f32x4){0.f, 0.f, 0.f, 0.f};
        cur = nxt; cA = nA; cB = nB; ++ui;
        if constexpr (ALIGN_EPI) { if (wr == 1) PG8_BAR; }
    }
    PG8_WAIT_V(0);
    if constexpr (!ALIGN_EPI) { if (wr == 0) PG8_BAR; }
    PG8_BAR;
    if constexpr (Epi::AFTER_DRAIN) { E.fused(acc, cur, wr, wc, fr, fq, lds, wid, lane); S.done(cur); }
#undef PG8_SA
#undef PG8_SB
#undef PG8_STAGE
#undef PG8_LDA
#undef PG8_LDB
#undef PG8_MMA
#undef PG8_WAIT_V
#undef PG8_WAIT_L
#undef PG8_BAR
#undef PG8_SCHED
}
}
#ifndef PG8_SP2
#define PG8_SP2 true
#endif
#ifndef PG8_ALIGN
#define PG8_ALIGN true
#endif
#define LAS __attribute__((address_space(3)))
#define DI __device__ __forceinline__
typedef unsigned short bf16;
typedef short bf16x8 __attribute__((ext_vector_type(8)));
typedef float f32x4 __attribute__((ext_vector_type(4)));
typedef unsigned u32x4 __attribute__((ext_vector_type(4)));
typedef unsigned u32x2 __attribute__((ext_vector_type(2)));
typedef float f32x2_t __attribute__((ext_vector_type(2)));
typedef __bf16 bf16x2_t __attribute__((ext_vector_type(2)));
typedef unsigned long long u64;

constexpr int S = 16384, D = 1024, DFF = 2816, NH = 16, HD = 64;
constexpr int NWAVES = 8, NTHR = 512;
constexpr float ALPHA_F = 1.681792830507429f;
constexpr float QSCALE = 0.125f * 1.4426950408889634f;
constexpr float LN_EPS = 1e-5f;
constexpr int LDS_BYTES = 147456;

constexpr size_t MiB = 1u << 20;
constexpr size_t WS_TAB = 1 * MiB;
constexpr size_t WS_BIAS = 2 * MiB;
constexpr size_t WS_KMEAN = 2 * MiB + 65536;
constexpr size_t WS_WA = 4 * MiB;
constexpr size_t WS_WVT = WS_WA + 4608 * 1024;
constexpr size_t WS_WO = WS_WVT + 2 * MiB;
constexpr size_t WS_WC1 = WS_WO + 2 * MiB;
constexpr size_t WS_WC2 = WS_WC1 + 2 * MiB;
constexpr size_t WS_WGU = WS_WC2 + 65536;
constexpr size_t WS_WD = WS_WGU + 11 * MiB;
static_assert(WS_WD + 5767168 <= 32 * MiB, "weights region");
constexpr size_t WS_XB = 32 * MiB;
constexpr size_t WS_ACT = 64 * MiB;
constexpr size_t WS_Q = WS_ACT;
constexpr size_t WS_O = WS_ACT + 32 * MiB;
constexpr size_t WS_KVC = WS_ACT + 64 * MiB;
constexpr size_t WS_KSEL = WS_KVC + 17 * MiB;
constexpr size_t WS_KWIN = WS_KSEL + 8 * MiB;
constexpr size_t WS_VSELT = WS_KWIN + 8 * MiB;
constexpr size_t WS_GATES = WS_VSELT + 16 * MiB;
constexpr size_t WS_HC = WS_GATES + 3 * MiB;
constexpr size_t WS_KC = WS_HC + 4 * MiB;
constexpr size_t WS_VCT = WS_KC + 512 * 1024;
constexpr size_t WS_MK = WS_ACT + 64 * MiB;
constexpr size_t WS_MVT = WS_MK + 32 * MiB;
constexpr size_t WS_H = WS_ACT;
constexpr size_t WS_END = 256 * MiB;
static_assert(WS_VCT + 512 * 1024 <= WS_END && WS_MVT + 32 * MiB <= WS_END && WS_H + (size_t)S * DFF * 2 <= WS_END, "ws map");

DI unsigned cvtpk(float lo, float hi) { f32x2_t v = {lo, hi}; bf16x2_t b = __builtin_convertvector(v, bf16x2_t); return __builtin_bit_cast(unsigned, b); }
DI float ex2(float x) { return __builtin_amdgcn_exp2f(x); }
DI bf16x8 ldg8(const bf16* p) { return *(const bf16x8*)p; }
#define MFMA16(a, b, c) __builtin_amdgcn_mfma_f32_16x16x32_bf16((a), (b), (c), 0, 0, 0)
#define LDS_WAIT() asm volatile("s_waitcnt lgkmcnt(0)" ::: "memory")
DI float wave_sum(float v) {
#pragma unroll
    for (int o = 1; o < 64; o <<= 1) v += __shfl_xor(v, o);
    return v;
}

struct Args { const float* in[19]; const int* pos; float* out; unsigned char* ws; };

struct CmpOrder {
    int G, c;
    __device__ bool next(int i, pg8::Unit& u) const { const int L = i * G + c; if (L >= 32) return false; u.pm = L; u.pn = L >> 4; return true; }
    DI void a_ready(const pg8::Unit&) const {}
    DI void done(const pg8::Unit&) const {}
};

DI void rope8(float (&v)[8], const float* tabrow, int fq) {
    float p[8];
#pragma unroll
    for (int i = 0; i < 8; ++i) p[i] = __shfl_xor(v[i], 16);
    if (fq < 2) {
        const f32x4 c0 = *(const f32x4*)(tabrow), c1 = *(const f32x4*)(tabrow + 4), s0 = *(const f32x4*)(tabrow + 8), s1 = *(const f32x4*)(tabrow + 12);
        const float cs[8] = {c0[0], c0[1], c0[2], c0[3], c1[0], c1[1], c1[2], c1[3]};
        const float sn[8] = {s0[0], s0[1], s0[2], s0[3], s1[0], s1[1], s1[2], s1[3]};
#pragma unroll
        for (int i = 0; i < 8; ++i) v[i] = (fq == 0) ? (v[i] * cs[i] - p[i] * sn[i]) : (v[i] * cs[i] + p[i] * sn[i]);
    }
}
DI u32x4 pack8(const float (&v)[8]) { u32x4 w; w.x = cvtpk(v[0], v[1]); w.y = cvtpk(v[2], v[3]); w.z = cvtpk(v[4], v[5]); w.w = cvtpk(v[6], v[7]); return w; }

struct EpiNsaA {
    static constexpr bool PERM = true, AFTER_DRAIN = false;
    bf16* q; bf16* kvc; bf16* ksel; bf16* kwin; float* gates; const float* tab;
    DI void operator()(const f32x4 (&acc)[2][2][4][2], const pg8::Unit& u, int wr, int wc, int fr, int fq) const {
        const int pn = u.pn;
        const bool rope = (pn != 7) && (pn != 8) && ((wc & 1) == 0);
#pragma unroll
        for (int ai = 0; ai < 2; ++ai)
#pragma unroll
            for (int m = 0; m < 4; ++m) {
                const int row = u.pm * 256 + ai * 128 + wr * 64 + m * 16 + fr;
#pragma unroll
                for (int bj = 0; bj < 2; ++bj) {
                    const int cb = bj * 128 + wc * 32 + 8 * fq;
                    float v[8];
#pragma unroll
                    for (int i = 0; i < 4; ++i) { v[i] = acc[ai][bj][m][0][i]; v[4 + i] = acc[ai][bj][m][1][i]; }
                    if (pn == 8) {
                        if (cb < 48) {
#pragma unroll
                            for (int i = 0; i < 8; ++i) v[i] = 1.0f / (1.0f + __expf(-v[i]));
                            float* gp = gates + (size_t)row * 48 + cb;
                            *(f32x4*)gp = (f32x4){v[0], v[1], v[2], v[3]}; *(f32x4*)(gp + 4) = (f32x4){v[4], v[5], v[6], v[7]};
                        }
                        continue;
                    }
                    if (rope) rope8(v, tab + (size_t)row * 16, fq);
                    if (pn < 4) {
#pragma unroll
                        for (int i = 0; i < 8; ++i) v[i] *= QSCALE;
                        *(u32x4*)(q + (size_t)row * 1024 + pn * 256 + cb) = pack8(v);
                    } else {
                        bf16* base = (pn == 4) ? kvc : (pn == 5) ? ksel : (pn == 6) ? kwin : (kvc + (size_t)4 * S * 64);
                        const int g = cb >> 6, d = cb & 63;
                        *(u32x4*)(base + ((size_t)g * S + row) * 64 + d) = pack8(v);
                    }
                }
            }
    }
};
struct EpiMobaA {
    static constexpr bool PERM = true, AFTER_DRAIN = false;
    bf16* q; bf16* k; const float* tab;
    DI void operator()(const f32x4 (&acc)[2][2][4][2], const pg8::Unit& u, int wr, int wc, int fr, int fq) const {
        const int pn = u.pn;
        const bool rope = ((wc & 1) == 0);
#pragma unroll
        for (int ai = 0; ai < 2; ++ai)
#pragma unroll
            for (int m = 0; m < 4; ++m) {
                const int row = u.pm * 256 + ai * 128 + wr * 64 + m * 16 + fr;
#pragma unroll
                for (int bj = 0; bj < 2; ++bj) {
                    const int cb = bj * 128 + wc * 32 + 8 * fq;
                    float v[8];
#pragma unroll
                    for (int i = 0; i < 4; ++i) { v[i] = acc[ai][bj][m][0][i]; v[4 + i] = acc[ai][bj][m][1][i]; }
                    if (rope) rope8(v, tab + (size_t)row * 16, fq);
                    if (pn < 4) {
#pragma unroll
                        for (int i = 0; i < 8; ++i) v[i] *= QSCALE;
                        *(u32x4*)(q + (size_t)row * 1024 + pn * 256 + cb) = pack8(v);
                    } else {
                        const int h = (pn - 4) * 4 + (cb >> 6), d = cb & 63;
                        *(u32x4*)(k + ((size_t)h * S + row) * 64 + d) = pack8(v);
                    }
                }
            }
    }
};
DI float gelu_tanh(float x) {
    const float u = 0.7978845608028654f * (x + 0.044715f * x * x * x);
    const float e = __expf(2.0f * u);
    const float t = 1.0f - 2.0f / (e + 1.0f);
    return 0.5f * x * (1.0f + t);
}
struct EpiCmp1 {
    static constexpr bool PERM = true, AFTER_DRAIN = false;
    bf16* H; const float* bias;
    DI void operator()(const f32x4 (&acc)[2][2][4][2], const pg8::Unit& u, int wr, int wc, int fr, int fq) const {
        const float* bb = bias + u.pn * 256;
#pragma unroll
        for (int ai = 0; ai < 2; ++ai)
#pragma unroll
            for (int m = 0; m < 4; ++m) {
                const int row = u.pm * 256 + ai * 128 + wr * 64 + m * 16 + fr;
#pragma unroll
                for (int bj = 0; bj < 2; ++bj) {
                    const int cb = bj * 128 + wc * 32 + 8 * fq;
                    const f32x4 b0 = *(const f32x4*)(bb + cb), b1 = *(const f32x4*)(bb + cb + 4);
                    float v[8];
#pragma unroll
                    for (int i = 0; i < 4; ++i) { v[i] = gelu_tanh(acc[ai][bj][m][0][i] + b0[i]); v[4 + i] = gelu_tanh(acc[ai][bj][m][1][i] + b1[i]); }
                    *(u32x4*)(H + (size_t)row * 256 + cb) = pack8(v);
                }
            }
    }
};
struct EpiResid {
    static constexpr bool PERM = false, AFTER_DRAIN = false;
    float* x;
    DI void operator()(const f32x4 (&acc)[2][2][4][2], const pg8::Unit& u, int wr, int wc, int fr, int fq) const {
#pragma unroll
        for (int ai = 0; ai < 2; ++ai)
#pragma unroll
            for (int m = 0; m < 4; ++m) {
                const int row = u.pm * 256 + ai * 128 + wr * 64 + m * 16 + fr;
                float* rp = x + (size_t)row * D + u.pn * 256 + wc * 32 + 4 * fq;
#pragma unroll
                for (int bj = 0; bj < 2; ++bj)
#pragma unroll
                    for (int n = 0; n < 2; ++n) {
                        f32x4* p = (f32x4*)(rp + bj * 128 + n * 16);
                        const f32x4 o = *p;
                        *p = o * ALPHA_F + acc[ai][bj][m][n];
                    }
            }
    }
};
struct EpiSwiglu {
    static constexpr bool PERM = true, AFTER_DRAIN = false;
    bf16* h;
    DI void operator()(const f32x4 (&acc)[2][2][4][2], const pg8::Unit& u, int wr, int wc, int fr, int fq) const {
#pragma unroll
        for (int ai = 0; ai < 2; ++ai)
#pragma unroll
            for (int m = 0; m < 4; ++m) {
                const int row = u.pm * 256 + ai * 128 + wr * 64 + m * 16 + fr;
                float v[8];
#pragma unroll
                for (int n = 0; n < 2; ++n)
#pragma unroll
                    for (int i = 0; i < 4; ++i) { const float g = acc[ai][0][m][n][i], uu = acc[ai][1][m][n][i]; v[4 * n + i] = g / (1.0f + __expf(-g)) * uu; }
                *(u32x4*)(h + (size_t)row * DFF + u.pn * 128 + wc * 32 + 8 * fq) = pack8(v);
            }
    }
};

DI void transpose_item(const float* W, int ldw, int ncols, bf16* WT, int ldt, int ilv, LAS float* scr, int item, int lane) {
    const int nblk = (ncols + 31) >> 5, kb = item / nblk, nb = item % nblk, k0 = 64 * kb, n0 = 32 * nb;
    const int cl = lane & 31; const bool cv = (n0 + cl) < ncols;
#pragma unroll 8
    for (int i = 0; i < 32; ++i) { const int kk = 2 * i + (lane >> 5); scr[kk * 33 + cl] = cv ? W[(size_t)(k0 + kk) * ldw + n0 + cl] : 0.f; }
    LDS_WAIT();
    const int c = lane & 7;
#pragma unroll
    for (int j = 0; j < 4; ++j) { const int n = (lane >> 3) + 8 * j; const LAS float* s = scr + (8 * c) * 33 + n;
        u32x4 o; o.x = cvtpk(s[0 * 33], s[1 * 33]); o.y = cvtpk(s[2 * 33], s[3 * 33]); o.z = cvtpk(s[4 * 33], s[5 * 33]); o.w = cvtpk(s[6 * 33], s[7 * 33]);
        const int ns = n0 + n; const int dr = ilv ? ((ns >> 7) * 256 + (ns & 127)) : ns;
        if (ns < ncols) *(u32x4*)(WT + (size_t)dr * ldt + k0 + 8 * c) = o; }
    LDS_WAIT();
}
struct ConvCtx { LAS float* scr; int gw, NGW, lane, base; };
DI void conv_job(ConvCtx& c, const float* W, int ldw, int K, int ncols, bf16* WT, int ldt, int ilv) {
    const int ni = (K / 64) * ((ncols + 31) >> 5);
    int first = c.gw - (c.base % c.NGW); if (first < 0) first += c.NGW;
    for (int it = first; it < ni; it += c.NGW) transpose_item(W, ldw, ncols, WT, ldt, ilv, c.scr, it, c.lane);
    c.base += ni;
}

DI void ln_row(float* xrow, bf16* brow, const float* gam, const float* bet, int lane) {
    f32x4* xr = (f32x4*)xrow + lane;
    f32x4 v[4]; float s = 0.f;
#pragma unroll
    for (int j = 0; j < 4; ++j) { v[j] = xr[64 * j]; s += (v[j][0] + v[j][1]) + (v[j][2] + v[j][3]); }
    const float mean = wave_sum(s) * (1.f / D); float s2 = 0.f;
#pragma unroll
    for (int j = 0; j < 4; ++j) { v[j] = v[j] - mean; s2 += (v[j][0] * v[j][0] + v[j][1] * v[j][1]) + (v[j][2] * v[j][2] + v[j][3] * v[j][3]); }
    const float rstd = 1.0f / sqrtf(wave_sum(s2) * (1.f / D) + LN_EPS);
#pragma unroll
    for (int j = 0; j < 4; ++j) {
        const f32x4 g = *((const f32x4*)gam + lane + 64 * j), b = *((const f32x4*)bet + lane + 64 * j);
        const f32x4 o = v[j] * rstd * g + b;
        xr[64 * j] = o;
        u32x2 w; w.x = cvtpk(o[0], o[1]); w.y = cvtpk(o[2], o[3]);
        *((u32x2*)brow + lane + 64 * j) = w;
    }
}

DI void sincos_d(double r, float& sn, float& cs) {
    const double z = r * r;
    double s = 1.0 / 15511210043330985984000000.0;
    s = s * z - 1.0 / 25852016738884976640000.0;
    s = s * z + 1.0 / 51090942171709440000.0;
    s = s * z - 1.0 / 121645100408832000.0;
    s = s * z + 1.0 / 355687428096000.0;
    s = s * z - 1.0 / 1307674368000.0;
    s = s * z + 1.0 / 6227020800.0;
    s = s * z - 1.0 / 39916800.0;
    s = s * z + 1.0 / 362880.0;
    s = s * z - 1.0 / 5040.0;
    s = s * z + 1.0 / 120.0;
    s = s * z - 1.0 / 6.0;
    s = s * z + 1.0;
    sn = (float)(s * r);
    double c = 1.0 / 620448401733239439360000.0;
    c = c * z - 1.0 / 1124000727777607680000.0;
    c = c * z + 1.0 / 2432902008176640000.0;
    c = c * z - 1.0 / 6402373705728000.0;
    c = c * z + 1.0 / 20922789888000.0;
    c = c * z - 1.0 / 87178291200.0;
    c = c * z + 1.0 / 479001600.0;
    c = c * z - 1.0 / 3628800.0;
    c = c * z + 1.0 / 40320.0;
    c = c * z - 1.0 / 720.0;
    c = c * z + 1.0 / 24.0;
    c = c * z - 0.5;
    c = c * z + 1.0;
    cs = (float)c;
}

DI bf16x8 sm_update(const f32x4& s0, const f32x4& s1, float& m, float& l, f32x4 (&O)[4]) {
    float mx = fmaxf(fmaxf(fmaxf(s0[0], s0[1]), fmaxf(s0[2], s0[3])), fmaxf(fmaxf(s1[0], s1[1]), fmaxf(s1[2], s1[3])));
    mx = fmaxf(mx, __shfl_xor(mx, 16)); mx = fmaxf(mx, __shfl_xor(mx, 32));
    const float mn = fmaxf(m, mx), alpha = ex2(m - mn);
    m = mn;
    float p[8];
#pragma unroll
    for (int i = 0; i < 4; ++i) { p[i] = ex2(s0[i] - mn); p[4 + i] = ex2(s1[i] - mn); }
    l = l * alpha + ((p[0] + p[1]) + (p[2] + p[3])) + ((p[4] + p[5]) + (p[6] + p[7]));
#pragma unroll
    for (int dt = 0; dt < 4; ++dt) O[dt] = O[dt] * alpha;
    u32x4 w; w.x = cvtpk(p[0], p[1]); w.y = cvtpk(p[2], p[3]); w.z = cvtpk(p[4], p[5]); w.w = cvtpk(p[6], p[7]);
    return __builtin_bit_cast(bf16x8, w);
}
DI void load_k(bf16x8 (&kA)[2][2], const bf16* K, int key0, int fr, int kg) {
    const bf16* p = K + (size_t)(key0 + 8 * (fr >> 2) + (fr & 3)) * 64 + 8 * kg;
    kA[0][0] = ldg8(p); kA[0][1] = ldg8(p + 32); kA[1][0] = ldg8(p + 4 * 64); kA[1][1] = ldg8(p + 4 * 64 + 32);
}
DI void load_vt(bf16x8 (&vA)[4], const bf16* VT, size_t ldv, int key0, int fr, int kg) {
    const bf16* p = VT + (size_t)fr * ldv + key0 + 8 * kg;
#pragma unroll
    for (int dt = 0; dt < 4; ++dt) vA[dt] = ldg8(p + (size_t)(16 * dt) * ldv);
}
DI void qk(f32x4& s0, f32x4& s1, const bf16x8 (&kA)[2][2], const bf16x8 (&qB)[2]) {
    const f32x4 z = {0.f, 0.f, 0.f, 0.f};
    s0 = MFMA16(kA[0][0], qB[0], z); s0 = MFMA16(kA[0][1], qB[1], s0);
    s1 = MFMA16(kA[1][0], qB[0], z); s1 = MFMA16(kA[1][1], qB[1], s1);
}

struct NsaT { const bf16* q; const bf16* ksel; const bf16* kwin; const bf16* vselT; const bf16* vwinT; const bf16* kc; const bf16* vcT; const float* gates; bf16* o; };

DI void nsa_unit(const NsaT& A, LAS unsigned char* lds, int T, int g, int w, int lane_in) {
    int lane = lane_in; asm volatile("" : "+v"(lane));
    const int fr = lane & 15, kg = lane >> 4;
    const int t0 = T * 128 + w * 16;
    const int blk = t0 >> 6;
    LAS float* imp = (LAS float*)(lds) + w * 4096;
    LAS unsigned* sb = (LAS unsigned*)(lds + 131072) + w * 128;
    bf16x8 qB[4][2];
    int tqc[4];
    const int head = 4 * g + (fr & 3);
#pragma unroll
    for (int qd = 0; qd < 4; ++qd) {
        tqc[qd] = t0 + 4 * qd + (fr >> 2);
        const bf16* qp = A.q + (size_t)tqc[qd] * 1024 + head * 64 + 8 * kg;
        qB[qd][0] = ldg8(qp); qB[qd][1] = ldg8(qp + 32);
    }
    const f32x4 z4 = {0.f, 0.f, 0.f, 0.f};
    f32x4 Oc[4][4];
#pragma unroll
    for (int a = 0; a < 4; ++a)
#pragma unroll
        for (int b = 0; b < 4; ++b) Oc[a][b] = z4;
    const bf16* kc = A.kc + (size_t)g * 1024 * 64;
    const bf16* vcT = A.vcT + (size_t)g * 64 * 1024;
    const int ncmp = t0 >> 4;
    const int nst = (ncmp + 31) >> 5;
    if (blk > 15) {
#pragma unroll 4
        for (int i = 0; i < 64; ++i) imp[lane + 64 * i] = 0.f;
    }
    if (nst > 0) {
        int ln_ = lane; asm volatile("" : "+v"(ln_)); const int fr = ln_ & 15, kg = ln_ >> 4; (void)fr; (void)kg;
        float m1[4], l1[4]; int lim[4];
#pragma unroll
        for (int qd = 0; qd < 4; ++qd) { m1[qd] = -1e30f; l1[qd] = 0.f; lim[qd] = (tqc[qd] - 31) >> 4; }
#pragma unroll 1
        for (int st = 0; st < nst; ++st) {
            const int n0 = 32 * st;
            bf16x8 kA[2][2]; load_k(kA, kc, n0, fr, kg);
#pragma unroll
            for (int qd = 0; qd < 4; ++qd) {
                f32x4 s0, s1; qk(s0, s1, kA, qB[qd]);
                float mx = -INFINITY;
#pragma unroll
                for (int i = 0; i < 4; ++i) {
                    s0[i] = (n0 + 8 * kg + i <= lim[qd]) ? s0[i] : -INFINITY;
                    s1[i] = (n0 + 8 * kg + 4 + i <= lim[qd]) ? s1[i] : -INFINITY;
                    mx = fmaxf(mx, fmaxf(s0[i], s1[i]));
                }
                const float mn = fmaxf(m1[qd], mx);
                float sum = 0.f;
#pragma unroll
                for (int i = 0; i < 4; ++i) sum += ex2(s0[i] - mn) + ex2(s1[i] - mn);
                l1[qd] = l1[qd] * ex2(m1[qd] - mn) + sum; m1[qd] = mn;
            }
        }
        float inv[4];
#pragma unroll
        for (int qd = 0; qd < 4; ++qd) {
            float mt = fmaxf(m1[qd], __shfl_xor(m1[qd], 16)); mt = fmaxf(mt, __shfl_xor(mt, 32));
            float lt = l1[qd] * ex2(m1[qd] - mt); lt += __shfl_xor(lt, 16); lt += __shfl_xor(lt, 32);
            m1[qd] = mt; inv[qd] = lt > 0.f ? 1.0f / lt : 0.f;
        }
        LDS_WAIT();
#pragma unroll 1
        for (int st = 0; st < nst; ++st) {
            const int n0 = 32 * st;
            bf16x8 kA[2][2]; load_k(kA, kc, n0, fr, kg);
            bf16x8 vA[4]; load_vt(vA, vcT, 1024, n0, fr, kg);
#pragma unroll
            for (int qd = 0; qd < 4; ++qd) {
                f32x4 s0, s1; qk(s0, s1, kA, qB[qd]);
                float p[8];
#pragma unroll
                for (int i = 0; i < 4; ++i) {
                    p[i] = (n0 + 8 * kg + i <= lim[qd]) ? ex2(s0[i] - m1[qd]) * inv[qd] : 0.f;
                    p[4 + i] = (n0 + 8 * kg + 4 + i <= lim[qd]) ? ex2(s1[i] - m1[qd]) * inv[qd] : 0.f;
                }
                u32x4 wv; wv.x = cvtpk(p[0], p[1]); wv.y = cvtpk(p[2], p[3]); wv.z = cvtpk(p[4], p[5]); wv.w = cvtpk(p[6], p[7]);
                const bf16x8 P = __builtin_bit_cast(bf16x8, wv);
#pragma unroll
                for (int dt = 0; dt < 4; ++dt) Oc[qd][dt] = MFMA16(vA[dt], P, Oc[qd][dt]);
                if (blk > 15) {
                    float a0 = 2.f * (p[0] + p[1] + p[2]) + p[3], b0 = p[3], a1 = 2.f * (p[4] + p[5] + p[6]) + p[7], b1 = p[7];
                    a0 += __shfl_xor(a0, 1); a0 += __shfl_xor(a0, 2);
                    b0 += __shfl_xor(b0, 1); b0 += __shfl_xor(b0, 2);
                    a1 += __shfl_xor(a1, 1); a1 += __shfl_xor(a1, 2);
                    b1 += __shfl_xor(b1, 1); b1 += __shfl_xor(b1, 2);
                    if ((fr & 3) == 0) {
                        const int jb = (n0 >> 2) + 2 * kg;
                        LAS float* ip = imp + (4 * qd + (fr >> 2)) * 256 + jb;
                        __hip_atomic_fetch_add(ip, a0, __ATOMIC_RELAXED, __HIP_MEMORY_SCOPE_WORKGROUP);
                        __hip_atomic_fetch_add(ip + 1, b0 + a1, __ATOMIC_RELAXED, __HIP_MEMORY_SCOPE_WORKGROUP);
                        if (jb + 2 < 256) __hip_atomic_fetch_add(ip + 2, b1, __ATOMIC_RELAXED, __HIP_MEMORY_SCOPE_WORKGROUP);
                    }
                }
            }
        }
    }
    LDS_WAIT();
    if (blk <= 15) {
#pragma unroll
        for (int k = 0; k < 2; ++k) { const int idx = lane + 64 * k; sb[idx] = ((idx & 7) == 0) ? ((2u << blk) - 1u) : 0u; }
    } else {
        for (int qi = 0; qi < 16; ++qi) {
            u64 key[4];
#pragma unroll
            for (int i = 0; i < 4; ++i) { const int j = lane + 64 * i; const float v = imp[qi * 256 + j];
                key[i] = (j >= 1 && j <= blk - 2) ? (((u64)__float_as_uint(v) << 32) | (u64)(255 - j)) : 0ull; }
            unsigned myword = 0u;
            for (int r = 0; r < 13; ++r) {
                u64 best = key[0] > key[1] ? key[0] : key[1]; const u64 b2 = key[2] > key[3] ? key[2] : key[3]; best = best > b2 ? best : b2;
#pragma unroll
                for (int o = 1; o < 64; o <<= 1) {
                    const u64 ot = ((u64)__shfl_xor((unsigned)(best >> 32), o) << 32) | (u64)__shfl_xor((unsigned)best, o);
                    best = ot > best ? ot : best;
                }
#pragma unroll
                for (int i = 0; i < 4; ++i) key[i] = (key[i] == best) ? 0ull : key[i];
                const int js = 255 - (int)(best & 0xffull);
                if ((js >> 5) == lane) myword |= 1u << (js & 31);
            }
            if (lane < 8) {
                if (lane == 0) myword |= 1u;
                if (((blk - 1) >> 5) == lane) myword |= 1u << ((blk - 1) & 31);
                if ((blk >> 5) == lane) myword |= 1u << (blk & 31);
                sb[qi * 8 + lane] = myword;
            }
        }
    }
    LDS_WAIT();
    LAS f32x4* park = (LAS f32x4*)imp;
#pragma unroll
    for (int qd = 0; qd < 4; ++qd) {
        const float g0 = A.gates[(size_t)tqc[qd] * 48 + 3 * head];
#pragma unroll
        for (int dt = 0; dt < 4; ++dt) park[(qd * 4 + dt) * 64 + lane] = Oc[qd][dt] * g0;
    }
    f32x4 Ob[4][4]; float m2[4], l2[4];
#pragma unroll
    for (int a = 0; a < 4; ++a) { m2[a] = -1e30f; l2[a] = 0.f;
#pragma unroll
        for (int b = 0; b < 4; ++b) Ob[a][b] = z4; }
    {
        int ln_ = lane; asm volatile("" : "+v"(ln_)); const int fr = ln_ & 15, kg = ln_ >> 4; (void)fr; (void)kg;
        const bf16* ks = A.ksel + (size_t)g * S * 64;
        const bf16* vsT = A.vselT + (size_t)g * 64 * S;
        unsigned W = 0u;
#pragma unroll 1
        for (int j = 0; j <= blk; ++j) {
            if ((j & 31) == 0) W = (lane < 16) ? sb[lane * 8 + (j >> 5)] : 0u;
            const unsigned m16 = (unsigned)__ballot((W >> (j & 31)) & 1u);
            if (m16 == 0u) continue;
#pragma unroll 1
            for (int hs = 0; hs < 2; ++hs) {
                const int key0 = 64 * j + 32 * hs;
                bf16x8 kA[2][2]; load_k(kA, ks, key0, fr, kg);
                bf16x8 vA[4]; load_vt(vA, vsT, S, key0, fr, kg);
#pragma unroll
                for (int qd = 0; qd < 4; ++qd) {
                    const unsigned qm = (m16 >> (4 * qd)) & 0xfu;
                    if (qm == 0u) continue;
                    const bool colsel = (qm >> (fr >> 2)) & 1u;
                    f32x4 s0, s1; qk(s0, s1, kA, qB[qd]);
#pragma unroll
                    for (int i = 0; i < 4; ++i) {
                        const bool v0 = colsel && (j < blk || key0 + 8 * kg + i <= tqc[qd]);
                        const bool v1 = colsel && (j < blk || key0 + 8 * kg + 4 + i <= tqc[qd]);
                        s0[i] = v0 ? s0[i] : -INFINITY; s1[i] = v1 ? s1[i] : -INFINITY;
                    }
                    const bf16x8 P = sm_update(s0, s1, m2[qd], l2[qd], Ob[qd]);
#pragma unroll
                    for (int dt = 0; dt < 4; ++dt) Ob[qd][dt] = MFMA16(vA[dt], P, Ob[qd][dt]);
                }
            }
        }
    }
    float g2w[4];
#pragma unroll
    for (int qd = 0; qd < 4; ++qd) {
        const float* gp = A.gates + (size_t)tqc[qd] * 48 + 3 * head;
        const float g1 = gp[1]; g2w[qd] = gp[2];
        float lt = l2[qd]; lt += __shfl_xor(lt, 16); lt += __shfl_xor(lt, 32);
        const float c1 = lt > 0.f ? g1 / lt : 0.f;
#pragma unroll
        for (int dt = 0; dt < 4; ++dt) { park[(qd * 4 + dt) * 64 + lane] = park[(qd * 4 + dt) * 64 + lane] + Ob[qd][dt] * c1; Ob[qd][dt] = z4; }
        m2[qd] = -1e30f; l2[qd] = 0.f;
    }
    {
        int ln_ = lane; asm volatile("" : "+v"(ln_)); const int fr = ln_ & 15, kg = ln_ >> 4; (void)fr; (void)kg;
        const bf16* kw = A.kwin + (size_t)g * S * 64;
        const bf16* vwT = A.vwinT + (size_t)g * 64 * S;
        int klo = t0 - 511; klo = klo < 0 ? 0 : klo; klo &= ~31;
        const int khi = (t0 + 15) & ~31;
#pragma unroll 1
        for (int key0 = klo; key0 <= khi; key0 += 32) {
            bf16x8 kA[2][2]; load_k(kA, kw, key0, fr, kg);
            bf16x8 vA[4]; load_vt(vA, vwT, S, key0, fr, kg);
            const bool needmask = (key0 + 31 > t0) || (key0 < t0 + 15 - 511);
#pragma unroll
            for (int qd = 0; qd < 4; ++qd) {
                f32x4 s0, s1; qk(s0, s1, kA, qB[qd]);
                if (needmask) {
#pragma unroll
                    for (int i = 0; i < 4; ++i) {
                        const int k0 = key0 + 8 * kg + i, k1 = k0 + 4;
                        s0[i] = (k0 <= tqc[qd] && k0 >= tqc[qd] - 511) ? s0[i] : -INFINITY;
                        s1[i] = (k1 <= tqc[qd] && k1 >= tqc[qd] - 511) ? s1[i] : -INFINITY;
                    }
                }
                const bf16x8 P = sm_update(s0, s1, m2[qd], l2[qd], Ob[qd]);
#pragma unroll
                for (int dt = 0; dt < 4; ++dt) Ob[qd][dt] = MFMA16(vA[dt], P, Ob[qd][dt]);
            }
        }
    }
#pragma unroll
    for (int qd = 0; qd < 4; ++qd) {
        float lt = l2[qd]; lt += __shfl_xor(lt, 16); lt += __shfl_xor(lt, 32);
        const float c2 = lt > 0.f ? g2w[qd] / lt : 0.f;
        bf16* op = A.o + (size_t)tqc[qd] * 1024 + head * 64 + 4 * kg;
#pragma unroll
        for (int dt = 0; dt < 4; ++dt) {
            const f32x4 o = park[(qd * 4 + dt) * 64 + lane] + Ob[qd][dt] * c2;
            u32x2 wv; wv.x = cvtpk(o[0], o[1]); wv.y = cvtpk(o[2], o[3]);
            *(u32x2*)(op + 16 * dt) = wv;
        }
    }
}

struct MobaT { const bf16* q; const bf16* k; const bf16* vT; const bf16* kmh; const bf16* kml; bf16* o; };
DI void ins3(u64 x, u64& k1, u64& k2, u64& k3) {
    const bool g1 = x > k1, g2 = x > k2, g3 = x > k3;
    const u64 n3 = g2 ? k2 : (g3 ? x : k3), n2 = g1 ? k1 : (g2 ? x : k2), n1 = g1 ? x : k1;
    k1 = n1; k2 = n2; k3 = n3;
}
DI void moba_unit(const MobaT& A, int h, int U, int w, int lane_in) {
    int lane = lane_in; asm volatile("" : "+v"(lane));
    const int fr = lane & 15, kg = lane >> 4;
    const int t0 = U * 512 + w * 64;
    const int cur = t0 >> 8;
    bf16x8 qB[4][2]; int tqc[4];
#pragma unroll
    for (int nt = 0; nt < 4; ++nt) {
        tqc[nt] = t0 + 16 * nt + fr;
        const bf16* qp = A.q + (size_t)tqc[nt] * 1024 + h * 64 + 8 * kg;
        qB[nt][0] = ldg8(qp); qB[nt][1] = ldg8(qp + 32);
    }
    const f32x4 z4 = {0.f, 0.f, 0.f, 0.f};
    u64 selm[4] = {0ull, 0ull, 0ull, 0ull};
    if (cur > 0) {
        const int nmt = (cur + 15) >> 4;
        u64 k1[4], k2[4], k3[4];
#pragma unroll
        for (int nt = 0; nt < 4; ++nt) { k1[nt] = 0ull; k2[nt] = 0ull; k3[nt] = 0ull; }
        for (int mt = 0; mt < nmt; ++mt) {
            const size_t off = ((size_t)(h * 64 + 16 * mt + fr)) * 64 + 8 * kg;
            const bf16x8 ah0 = ldg8(A.kmh + off), ah1 = ldg8(A.kmh + off + 32), al0 = ldg8(A.kml + off), al1 = ldg8(A.kml + off + 32);
#pragma unroll
            for (int nt = 0; nt < 4; ++nt) {
                f32x4 s = MFMA16(ah0, qB[nt][0], z4); s = MFMA16(ah1, qB[nt][1], s); s = MFMA16(al0, qB[nt][0], s); s = MFMA16(al1, qB[nt][1], s);
#pragma unroll
                for (int i = 0; i < 4; ++i) {
                    const int b = 16 * mt + 4 * kg + i;
                    unsigned ub = __float_as_uint(s[i]); ub = (ub & 0x80000000u) ? ~ub : (ub | 0x80000000u);
                    const u64 x = (b < cur) ? (((u64)ub << 32) | (u64)(63 - b)) : 0ull;
                    ins3(x, k1[nt], k2[nt], k3[nt]);
                }
            }
        }
#pragma unroll
        for (int nt = 0; nt < 4; ++nt) {
#pragma unroll
            for (int o = 16; o < 64; o <<= 1) {
                const u64 p1 = ((u64)__shfl_xor((unsigned)(k1[nt] >> 32), o) << 32) | (u64)__shfl_xor((unsigned)k1[nt], o);
                const u64 p2 = ((u64)__shfl_xor((unsigned)(k2[nt] >> 32), o) << 32) | (u64)__shfl_xor((unsigned)k2[nt], o);
                const u64 p3 = ((u64)__shfl_xor((unsigned)(k3[nt] >> 32), o) << 32) | (u64)__shfl_xor((unsigned)k3[nt], o);
                ins3(p1, k1[nt], k2[nt], k3[nt]); ins3(p2, k1[nt], k2[nt], k3[nt]); ins3(p3, k1[nt], k2[nt], k3[nt]);
            }
            u64 sm = 0ull;
            if (k1[nt]) sm |= 1ull << (63 - (int)(k1[nt] & 63ull));
            if (k2[nt]) sm |= 1ull << (63 - (int)(k2[nt] & 63ull));
            if (k3[nt]) sm |= 1ull << (63 - (int)(k3[nt] & 63ull));
            selm[nt] = sm;
        }
    }
    f32x4 O[4][4]; float m[4], l[4];
#pragma unroll
    for (int a = 0; a < 4; ++a) { m[a] = -1e30f; l[a] = 0.f;
#pragma unroll
        for (int b = 0; b < 4; ++b) O[a][b] = z4; }
    const bf16* K = A.k + (size_t)h * S * 64;
    const bf16* VT = A.vT + (size_t)h * 64 * S;
    for (int b = 0; b < cur; ++b) {
        bool act[4]; bool any = false;
#pragma unroll
        for (int nt = 0; nt < 4; ++nt) { act[nt] = __ballot((selm[nt] >> b) & 1ull) != 0ull; any = any || act[nt]; }
        if (!any) continue;
#pragma unroll 1
        for (int st = 0; st < 8; ++st) {
            const int key0 = 256 * b + 32 * st;
            bf16x8 kA[2][2]; load_k(kA, K, key0, fr, kg);
            bf16x8 vA[4]; load_vt(vA, VT, S, key0, fr, kg);
#pragma unroll
            for (int nt = 0; nt < 4; ++nt) {
                if (!act[nt]) continue;
                const bool colsel = (selm[nt] >> b) & 1ull;
                f32x4 s0, s1; qk(s0, s1, kA, qB[nt]);
#pragma unroll
                for (int i = 0; i < 4; ++i) { s0[i] = colsel ? s0[i] : -INFINITY; s1[i] = colsel ? s1[i] : -INFINITY; }
                const bf16x8 P = sm_update(s0, s1, m[nt], l[nt], O[nt]);
#pragma unroll
                for (int dt = 0; dt < 4; ++dt) O[nt][dt] = MFMA16(vA[dt], P, O[nt][dt]);
            }
        }
    }
#pragma unroll 1
    for (int key0 = 256 * cur; key0 <= t0 + 32; key0 += 32) {
        bf16x8 kA[2][2]; load_k(kA, K, key0, fr, kg);
        bf16x8 vA[4]; load_vt(vA, VT, S, key0, fr, kg);
#pragma unroll
        for (int nt = 0; nt < 4; ++nt) {
            if (key0 > t0 + 16 * nt + 15) continue;
            f32x4 s0, s1; qk(s0, s1, kA, qB[nt]);
            if (key0 + 31 > t0 + 16 * nt) {
#pragma unroll
                for (int i = 0; i < 4; ++i) {
                    s0[i] = (key0 + 8 * kg + i <= tqc[nt]) ? s0[i] : -INFINITY;
                    s1[i] = (key0 + 8 * kg + 4 + i <= tqc[nt]) ? s1[i] : -INFINITY;
                }
            }
            const bf16x8 P = sm_update(s0, s1, m[nt], l[nt], O[nt]);
#pragma unroll
            for (int dt = 0; dt < 4; ++dt) O[nt][dt] = MFMA16(vA[dt], P, O[nt][dt]);
        }
    }
#pragma unroll
    for (int nt = 0; nt < 4; ++nt) {
        float lt = l[nt]; lt += __shfl_xor(lt, 16); lt += __shfl_xor(lt, 32);
        const float c = lt > 0.f ? 1.0f / lt : 0.f;
        bf16* op = A.o + (size_t)tqc[nt] * 1024 + h * 64 + 4 * kg;
#pragma unroll
        for (int dt = 0; dt < 4; ++dt) {
            const f32x4 o = O[nt][dt] * c;
            u32x2 wv; wv.x = cvtpk(o[0], o[1]); wv.y = cvtpk(o[2], o[3]);
            *(u32x2*)(op + 16 * dt) = wv;
        }
    }
}

__global__ void __launch_bounds__(NTHR, 2) trunk_fwd(Args args) {
    extern __shared__ __attribute__((aligned(16))) unsigned char lds_raw[];
    LAS unsigned char* lds = (LAS unsigned char*)lds_raw;
    cg::grid_group grid = cg::this_grid();
    const int G = gridDim.x, bx = blockIdx.x, NGW = G * NWAVES;
#define FRESH_Z() ({ size_t z_ = 0; asm volatile("" : "+s"(z_)); z_; })
#define FRESH_WS() (args.ws + FRESH_Z())
#define FRESH_X() (args.out + FRESH_Z())
#define FRESH_IN(i) (args.in[i] + FRESH_Z())
#define PTRS() int tid = threadIdx.x; asm volatile("" : "+v"(tid)); const int lane = tid & 63, wave = __builtin_amdgcn_readfirstlane(tid >> 6), gw = bx * NWAVES + wave; (void)lane; (void)gw; \
    unsigned char* ws = FRESH_WS(); float* X = FRESH_X(); \
    bf16* XB = (bf16*)(ws + WS_XB); float* TAB = (float*)(ws + WS_TAB); float* BIAS = (float*)(ws + WS_BIAS); \
    bf16* KMH = (bf16*)(ws + WS_KMEAN); bf16* KML = KMH + 16 * 64 * 64; \
    bf16* WA = (bf16*)(ws + WS_WA); bf16* WVT = (bf16*)(ws + WS_WVT); bf16* WO = (bf16*)(ws + WS_WO); \
    bf16* WC1 = (bf16*)(ws + WS_WC1); bf16* WC2 = (bf16*)(ws + WS_WC2); bf16* WGU = (bf16*)(ws + WS_WGU); bf16* WD = (bf16*)(ws + WS_WD); \
    bf16* Qb = (bf16*)(ws + WS_Q); bf16* Ob = (bf16*)(ws + WS_O); \
    bf16* KVC = (bf16*)(ws + WS_KVC); bf16* KSEL = (bf16*)(ws + WS_KSEL); bf16* KWIN = (bf16*)(ws + WS_KWIN); bf16* VSELT = (bf16*)(ws + WS_VSELT); \
    float* GATES = (float*)(ws + WS_GATES); bf16* HC = (bf16*)(ws + WS_HC); bf16* KC = (bf16*)(ws + WS_KC); bf16* VCT = (bf16*)(ws + WS_VCT); \
    bf16* MK = (bf16*)(ws + WS_MK); bf16* MVT = (bf16*)(ws + WS_MVT); bf16* HB = (bf16*)(ws + WS_H); \
    (void)X; (void)XB; (void)TAB; (void)BIAS; (void)KMH; (void)KML; (void)WA; (void)WVT; (void)WO; (void)WC1; (void)WC2; (void)WGU; (void)WD; (void)Qb; (void)Ob; \
    (void)KVC; (void)KSEL; (void)KWIN; (void)VSELT; (void)GATES; (void)HC; (void)KC; (void)VCT; (void)MK; (void)MVT; (void)HB;
    {
        PTRS();
        const f32x4* x4 = (const f32x4*)FRESH_IN(0); f32x4* o4 = (f32x4*)X; u32x2* b2 = (u32x2*)XB;
        for (size_t i = (size_t)bx * NTHR + tid; i < (size_t)S * D / 4; i += (size_t)G * NTHR) {
            const f32x4 v = x4[i]; o4[i] = v; u32x2 w; w.x = cvtpk(v[0], v[1]); w.y = cvtpk(v[2], v[3]); b2[i] = w; }
        for (int i = bx * NTHR + tid; i < S * 8; i += G * NTHR) {
            const int t = i >> 3, f = i & 7;
            const float invf = f == 0 ? 1.0f : f == 1 ? 0.19392274f : f == 2 ? 0.03760603f : f == 3 ? 0.0072926646f : f == 4 ? 0.0014142136f : f == 5 ? 0.0002742482f : f == 6 ? 5.3182957e-05f : 1.0313385e-05f;
            const float ang = (float)args.pos[t] * invf;
            const double a = (double)ang, k = __builtin_rint(a * 0.15915494309189535), r = a - k * 6.283185307179586476925;
            float sn, cs; sincos_d(r, sn, cs);
            TAB[t * 16 + f] = cs; TAB[t * 16 + 8 + f] = sn;
        }
    }

    for (int li = 0; li < 4; ++li) {
        const int lj = li >> 1; const bool nsa = (li & 1) == 0;
        {
            PTRS();
            ConvCtx c; c.scr = (LAS float*)(lds + wave * 16384); c.gw = gw; c.NGW = NGW; c.lane = lane; c.base = 0;
            if (nsa) {
                const float* win = FRESH_IN(2) + (size_t)lj * 1024 * 2608;
                conv_job(c, win, 2608, 1024, 1024, WA, 1024, 0);
                conv_job(c, win + 1024, 2608, 1024, 256, WA + (size_t)1024 * 1024, 1024, 0);
                conv_job(c, win + 1024 + 512, 2608, 1024, 256, WA + (size_t)1280 * 1024, 1024, 0);
                conv_job(c, win + 1024 + 1024, 2608, 1024, 256, WA + (size_t)1536 * 1024, 1024, 0);
                conv_job(c, win + 1024 + 256, 2608, 1024, 256, WA + (size_t)1792 * 1024, 1024, 0);
                conv_job(c, win + 2560, 2608, 1024, 48, WA + (size_t)2048 * 1024, 1024, 0);
                conv_job(c, win + 1024 + 768, 2608, 1024, 256, WVT, 1024, 0);
                conv_job(c, win + 1024 + 1280, 2608, 1024, 256, WVT + (size_t)256 * 1024, 1024, 0);
                conv_job(c, FRESH_IN(3) + (size_t)lj * 1024 * 1024, 1024, 1024, 1024, WO, 1024, 0);
                conv_job(c, FRESH_IN(5) + (size_t)lj * 2048 * 256, 256, 2048, 256, WC1, 2048, 0);
                conv_job(c, FRESH_IN(8) + (size_t)lj * 2048 * 256, 256, 2048, 256, WC1 + (size_t)256 * 2048, 2048, 0);
                conv_job(c, FRESH_IN(6) + (size_t)lj * 256 * 64, 64, 256, 64, WC2, 256, 0);
                conv_job(c, FRESH_IN(9) + (size_t)lj * 256 * 64, 64, 256, 64, WC2 + 64 * 256, 256, 0);
            } else {
                const float* win = FRESH_IN(10) + (size_t)lj * 1024 * 3072;
                conv_job(c, win, 3072, 1024, 2048, WA, 1024, 0);
                conv_job(c, win + 2048, 3072, 1024, 1024, WVT, 1024, 0);
                conv_job(c, FRESH_IN(11) + (size_t)lj * 1024 * 1024, 1024, 1024, 1024, WO, 1024, 0);
            }
            conv_job(c, FRESH_IN(12) + (size_t)li * 1024 * DFF, DFF, 1024, DFF, WGU, 1024, 1);
            conv_job(c, FRESH_IN(13) + (size_t)li * 1024 * DFF, DFF, 1024, DFF, WGU + (size_t)128 * 1024, 1024, 1);
            conv_job(c, FRESH_IN(14) + (size_t)li * DFF * 1024, 1024, DFF, 1024, WD, DFF, 0);
            if (nsa) {
                for (int it = gw; it < 128; it += NGW) {
                    const int kv = it >> 6, c4 = (it & 63) * 4;
                    const float* pe = FRESH_IN(kv ? 7 : 4) + (size_t)lj * 2048;
                    const float* w1 = FRESH_IN(kv ? 8 : 5) + (size_t)lj * 2048 * 256;
                    f32x4 s = {0.f, 0.f, 0.f, 0.f};
                    for (int r = lane; r < 2048; r += 64) { const f32x4 wv = *(const f32x4*)(w1 + (size_t)r * 256 + c4); s = s + wv * pe[r]; }
                    s[0] = wave_sum(s[0]); s[1] = wave_sum(s[1]); s[2] = wave_sum(s[2]); s[3] = wave_sum(s[3]);
                    if (lane == 0) *(f32x4*)(BIAS + kv * 256 + c4) = s;
                }
                if (bx == 0) { u32x4* z = (u32x4*)(KVC + (size_t)8 * S * 64); unsigned z0 = 0u; asm volatile("" : "+v"(z0)); if (tid < 256) z[tid] = (u32x4){z0, z0, z0, z0}; }
            }
        }
        grid.sync();
        if (nsa) {
            {
                PTRS();
                pg8::Gemm g{XB, WA, S, 2304, 1024, 1024}; pg8::StaticOrder so; so.init(S, 2304, G, bx);
                EpiNsaA E{Qb, KVC, KSEL, KWIN, GATES, TAB};
                pg8::gemm_phase<EpiNsaA, pg8::StaticOrder, PG8_ALIGN, PG8_SP2>(lds, g, so, E);
            }
            {
                PTRS();
                pg8::Gemm g{WVT, XB, 512, S, 1024, 1024}; pg8::StaticOrder so; so.init(512, S, G, bx);
                pg8::EpiBf16<0> E{VSELT, S, nullptr, 0, 0, 1.f};
                pg8::gemm_phase<pg8::EpiBf16<0>, pg8::StaticOrder, PG8_ALIGN, PG8_SP2>(lds, g, so, E);
            }
            grid.sync();
            {
                PTRS();
                pg8::Gemm g{KVC, WC1, 8192, 512, 2048, 1024}; CmpOrder so{G, bx};
                EpiCmp1 E{HC, BIAS};
                pg8::gemm_phase<EpiCmp1, CmpOrder, PG8_ALIGN, PG8_SP2>(lds, g, so, E);
            }
            grid.sync();
            { PTRS();
            for (int it = gw; it < 512; it += NGW) {
                const int fr = lane & 15, kg = lane >> 4;
                const int r0 = it * 16, kv = r0 >> 12, gg = (r0 >> 10) & 3, n = (r0 & 1023) + fr;
                const bf16* hp = HC + (size_t)(r0 + fr) * 256 + 8 * kg;
                const bf16* wp = WC2 + (size_t)(kv * 64 + fr) * 256 + 8 * kg;
                f32x4 C[4] = {{0.f, 0.f, 0.f, 0.f}, {0.f, 0.f, 0.f, 0.f}, {0.f, 0.f, 0.f, 0.f}, {0.f, 0.f, 0.f, 0.f}};
#pragma unroll
                for (int ks = 0; ks < 8; ++ks) {
                    const bf16x8 b = ldg8(hp + 32 * ks);
#pragma unroll
                    for (int dt = 0; dt < 4; ++dt) C[dt] = MFMA16(ldg8(wp + (size_t)(16 * dt) * 256 + 32 * ks), b, C[dt]);
                }
                if (kv == 0) {
#pragma unroll
                    for (int dt = 0; dt < 4; ++dt) { u32x2 wv; wv.x = cvtpk(C[dt][0], C[dt][1]); wv.y = cvtpk(C[dt][2], C[dt][3]);
                        *(u32x2*)(KC + ((size_t)gg * 1024 + n) * 64 + 16 * dt + 4 * kg) = wv; }
                } else {
#pragma unroll
                    for (int dt = 0; dt < 4; ++dt)
#pragma unroll
                        for (int i = 0; i < 4; ++i) VCT[((size_t)gg * 64 + 16 * dt + 4 * kg + i) * 1024 + n] = (bf16)(cvtpk(C[dt][i], 0.f) & 0xffffu);
                }
            }
            }
            grid.sync();
            {
                PTRS();
                NsaT A{Qb, KSEL, KWIN, VSELT, VSELT + (size_t)256 * S, KC, VCT, GATES, Ob};
                for (int it = bx; it < 512; it += G) {
                    const int half = it >> 8, bb = it & 255, tb = bb >> 2, g = bb & 3;
                    const int T = half ? 127 - tb : tb;
#ifndef NO_NSA
                    nsa_unit(A, lds, T, g, wave, lane);
#endif
                }
            }
            grid.sync();
        } else {
            {
                PTRS();
                pg8::Gemm g{XB, WA, S, 2048, 1024, 1024}; pg8::StaticOrder so; so.init(S, 2048, G, bx);
                EpiMobaA E{Qb, MK, TAB};
                pg8::gemm_phase<EpiMobaA, pg8::StaticOrder, PG8_ALIGN, PG8_SP2>(lds, g, so, E);
            }
            {
                PTRS();
                pg8::Gemm g{WVT, XB, 1024, S, 1024, 1024}; pg8::StaticOrder so; so.init(1024, S, G, bx);
                pg8::EpiBf16<0> E{MVT, S, nullptr, 0, 0, 1.f};
                pg8::gemm_phase<pg8::EpiBf16<0>, pg8::StaticOrder, PG8_ALIGN, PG8_SP2>(lds, g, so, E);
            }
            grid.sync();
            { PTRS();
            for (int it = gw; it < 1024; it += NGW) {
                const int h = it >> 6, b = it & 63, rg = lane >> 3, c8 = lane & 7;
                const bf16* kp = MK + ((size_t)h * S + b * 256 + rg) * 64 + 8 * c8;
                float acc[8] = {0.f, 0.f, 0.f, 0.f, 0.f, 0.f, 0.f, 0.f};
#pragma unroll 4
                for (int r = 0; r < 32; ++r) { const bf16x8 v = ldg8(kp + (size_t)(8 * r) * 64);
#pragma unroll
                    for (int i = 0; i < 8; ++i) acc[i] += __uint_as_float(((unsigned)(unsigned short)v[i]) << 16); }
#pragma unroll
                for (int i = 0; i < 8; ++i) { acc[i] += __shfl_xor(acc[i], 8); acc[i] += __shfl_xor(acc[i], 16); acc[i] += __shfl_xor(acc[i], 32); acc[i] *= (1.0f / 256.0f); }
                if (lane < 8) {
                    float hi[8], lo[8];
#pragma unroll
                    for (int i = 0; i < 8; ++i) { const unsigned hb = cvtpk(acc[i], 0.f) & 0xffffu; hi[i] = __uint_as_float(hb << 16); lo[i] = acc[i] - hi[i]; }
                    *(u32x4*)(KMH + ((size_t)h * 64 + b) * 64 + 8 * c8) = pack8(hi);
                    *(u32x4*)(KML + ((size_t)h * 64 + b) * 64 + 8 * c8) = pack8(lo);
                }
            }
            }
            grid.sync();
            {
                PTRS();
                MobaT A{Qb, MK, MVT, KMH, KML, Ob};
                for (int it = bx; it < 512; it += G) {
                    const int half = it >> 8, bb = it & 255, h = bb & 15, ub = bb >> 4;
                    const int U = half ? 31 - ub : ub;
#ifndef NO_MOBA
                    moba_unit(A, h, U, wave, lane);
#endif
                }
            }
            grid.sync();
        }
        {
            PTRS();
            pg8::Gemm g{Ob, WO, S, 1024, 1024, 1024}; pg8::StaticOrder so; so.init(S, 1024, G, bx);
            EpiResid E{X};
            pg8::gemm_phase<EpiResid, pg8::StaticOrder, PG8_ALIGN, PG8_SP2>(lds, g, so, E);
        }
        grid.sync();
        { PTRS(); const float* gg_ = FRESH_IN(15) + li * D; const float* bb_ = FRESH_IN(16) + li * D;
          for (int r = gw; r < S; r += NGW) ln_row(X + (size_t)r * D, XB + (size_t)r * D, gg_, bb_, lane); }
        grid.sync();
        {
            PTRS();
            pg8::Gemm g{XB, WGU, S, 2 * DFF, 1024, 1024}; pg8::StaticOrder so; so.init(S, 2 * DFF, G, bx);
            EpiSwiglu E{HB};
            pg8::gemm_phase<EpiSwiglu, pg8::StaticOrder, PG8_ALIGN, PG8_SP2>(lds, g, so, E);
        }
        grid.sync();
        {
            PTRS();
            pg8::Gemm g{HB, WD, S, 1024, DFF, DFF}; pg8::StaticOrder so; so.init(S, 1024, G, bx);
            EpiResid E{X};
            pg8::gemm_phase<EpiResid, pg8::StaticOrder, PG8_ALIGN, PG8_SP2>(lds, g, so, E);
        }
        grid.sync();
        { PTRS(); const float* gg_ = FRESH_IN(17) + li * D; const float* bb_ = FRESH_IN(18) + li * D;
          for (int r = gw; r < S; r += NGW) ln_row(X + (size_t)r * D, XB + (size_t)r * D, gg_, bb_, lane); }
        grid.sync();
    }
}

extern "C" void kernel_launch(void* const* d_in, const int* in_sizes, int n_in, void* d_out, int out_size, void* d_ws, size_t ws_size, hipStream_t stream) {
    static int grid = 0;
    if (grid == 0) {
        int dev = 0, cus = 0, per_cu = 0;
        hipGetDevice(&dev);
        hipDeviceGetAttribute(&cus, hipDeviceAttributeMultiprocessorCount, dev);
        hipFuncSetAttribute((const void*)trunk_fwd, hipFuncAttributeMaxDynamicSharedMemorySize, LDS_BYTES);
        hipOccupancyMaxActiveBlocksPerMultiprocessor(&per_cu, (const void*)trunk_fwd, NTHR, LDS_BYTES);
        if (per_cu < 1) { fprintf(stderr, "kernel_launch: occupancy query says %d blocks per CU\n", per_cu); per_cu = 1; }
        if (per_cu > 1) per_cu = 1;
        grid = cus * per_cu;
        (void)hipGetLastError();
    }
    Args a{};
    for (int i = 0; i < 19; ++i) a.in[i] = (const float*)d_in[i];
    a.pos = (const int*)d_in[1]; a.out = (float*)d_out; a.ws = (unsigned char*)d_ws;
    void* kargs[] = {&a};
    hipError_t e = hipLaunchCooperativeKernel((const void*)trunk_fwd, dim3(grid), dim3(NTHR), kargs, LDS_BYTES, stream);
    if (e != hipSuccess) fprintf(stderr, "cooperative launch failed: %s (grid %d)\n", hipGetErrorString(e), grid);
}
```

```cpp
#include <hip/hip_runtime.h>
#include <hip/hip_cooperative_groups.h>
#include <cstdio>
#include <cstdint>
namespace cg = cooperative_groups;
namespace pg8 {
#define PG8_LAS __attribute__((address_space(3)))
typedef unsigned short bf16_t;
typedef short bf16x8 __attribute__((ext_vector_type(8)));
typedef float f32x4 __attribute__((ext_vector_type(4)));
typedef unsigned u32x4 __attribute__((ext_vector_type(4)));
constexpr int BM = 256, BK = 64, HALF = 128, HTB = HALF * BK * 2  , STAGE_BYTES = 8 * HTB, NXCD = 8, WGM = 8;

__host__ __device__ __forceinline__ int lds_byte(int r, int c) { const int st = (r >> 4) * 2 + (c >> 5), rr = r & 15, cc = c & 31, ob = rr * 64 + cc * 2; return st * 1024 + (ob ^ (((ob >> 9) & 1) << 5)); }
__host__ __device__ __forceinline__ void stage_rc(int b, int& R, int& C) { const int st = b / 1024, sb = b % 1024, swz = sb ^ (((sb >> 9) & 1) << 5); R = (st >> 1) * 16 + swz / 64; C = (st & 1) * 32 + (swz % 64) / 2; }
__host__ __device__ __forceinline__ int perm32(int rho) { const int n = rho >> 4, i = rho & 15; return 8 * (i >> 2) + 4 * n + (i & 3); }

struct Unit { int pm, pn; };
struct Gemm { const bf16_t* A; const bf16_t* Bt; int M, N, K, lda; };

struct StaticOrder {
    int nM, nN, nwg, G, c;
    __host__ __device__ void init(int M, int N, int G_, int c_) { nM = M / BM; nN = N / BM; nwg = nM * nN; G = G_; c = c_; }
    __host__ __device__ bool next(int i, Unit& u) const {
        const long L = (long)i * G + c; if (L >= nwg) return false;
        int wgid = (int)L; { const int q = nwg / NXCD, r = nwg % NXCD, xcd = wgid % NXCD, off = wgid / NXCD; wgid = (xcd < r ? xcd * (q + 1) : r * (q + 1) + (xcd - r) * q) + off; }
        const int nig = WGM * nN, gid = wgid / nig, fm = gid * WGM, gsz = (nM - fm) < WGM ? (nM - fm) : WGM;
        u.pm = fm + ((wgid % nig) % gsz); u.pn = (wgid % nig) / gsz; return true;
    }
    __device__ __forceinline__ void a_ready(const Unit&) const {}
    __device__ __forceinline__ void done(const Unit&) const {}
};

__device__ __forceinline__ unsigned cvt_pk_bf16(float lo, float hi) { unsigned r; asm volatile("v_cvt_pk_bf16_f32 %0, %1, %2" : "=v"(r) : "v"(lo), "v"(hi)); return r; }
typedef float f32x2 __attribute__((ext_vector_type(2)));
__device__ __forceinline__ f32x2 gelu_pk(f32x2 v) {
    const f32x2 av = __builtin_elementwise_abs(v), d = av * 0.2316418882f + 1.0f;
    f32x2 t; t.x = __builtin_amdgcn_rcpf(d.x); t.y = __builtin_amdgcn_rcpf(d.y);
    f32x2 q = t * 0.5307027145f + (-0.7265760135f); q = q * t + 0.7107068705f; q = q * t + (-0.142248368f); q = q * t + 0.127414796f; q = q * t;
    const f32x2 s = (v * v) * (-0.72134752044f);
    f32x2 e; e.x = __builtin_amdgcn_exp2f(s.x); e.y = __builtin_amdgcn_exp2f(s.y);
    const f32x2 m = v * (q * e), r = v - m;
    f32x2 o; o.x = v.x < 0.f ? m.x : r.x; o.y = v.y < 0.f ? m.y : r.y; return o;
}

template <int ACT  > struct EpiBf16 {
    static constexpr bool PERM = true, AFTER_DRAIN = false; static_assert(ACT == 0 || ACT == 1, "EpiBf16: ACT is 0 (none) or 1 (gelu_pk)");
    bf16_t* O; int ldc; const float* bias; int split_cols; size_t split_stride; float scale0;
    __device__ __forceinline__ void operator()(const f32x4 (&acc)[2][2][4][2], const Unit& u, int wr, int wc, int fr, int fq) const {
        const int row0 = u.pm * BM + wr * 64 + fr; int colt = u.pn * BM; bf16_t* base = O;
        float sc = 1.f; if (split_cols) { const int t = colt / split_cols; base += (size_t)t * split_stride; colt -= t * split_cols; if (t == 0) sc = scale0; }
        const int col0 = colt + wc * 32 + 8 * fq, bcol0 = u.pn * BM + wc * 32 + 8 * fq;
        f32x4 bv[2][2];
#pragma unroll
        for (int bj = 0; bj < 2; ++bj)
#pragma unroll
            for (int n = 0; n < 2; ++n) bv[bj][n] = bias ? *(const f32x4*)(bias + bcol0 + bj * HALF + 4 * n) : (f32x4){0.f, 0.f, 0.f, 0.f};
#pragma unroll
        for (int ai = 0; ai < 2; ++ai)
#pragma unroll
            for (int m = 0; m < 4; ++m) { bf16_t* rowp = base + (size_t)(row0 + ai * HALF + m * 16) * ldc + col0;
#pragma unroll
                for (int bj = 0; bj < 2; ++bj) { f32x4 v0 = acc[ai][bj][m][0] + bv[bj][0], v1 = acc[ai][bj][m][1] + bv[bj][1];
                    if (ACT == 1) { f32x2 a = gelu_pk((f32x2){v0[0], v0[1]}), b = gelu_pk((f32x2){v0[2], v0[3]}), c = gelu_pk((f32x2){v1[0], v1[1]}), d = gelu_pk((f32x2){v1[2], v1[3]});
                        v0 = (f32x4){a.x, a.y, b.x, b.y}; v1 = (f32x4){c.x, c.y, d.x, d.y}; }
                    v0 = v0 * sc; v1 = v1 * sc; u32x4 w; w.x = cvt_pk_bf16(v0[0], v0[1]); w.y = cvt_pk_bf16(v0[2], v0[3]); w.z = cvt_pk_bf16(v1[0], v1[1]); w.w = cvt_pk_bf16(v1[2], v1[3]);
                    *(u32x4*)(rowp + bj * HALF) = w; } }
    }
};
template <class Epi, class Sched, bool ALIGN_EPI = false, bool SP2 = false>
__device__ __forceinline__ void gemm_phase(PG8_LAS unsigned char* lds, const Gemm g, const Sched& S, const Epi& E, int tid_in) {
    int tid_l = tid_in; asm volatile("" : "+v"(tid_l)); const int tid = tid_l, wid = __builtin_amdgcn_readfirstlane(tid >> 6), lane = tid & 63, wr = wid >> 2, wc = wid & 3, fr = lane & 15, fq = lane >> 4;
    const int K = g.K, nt = K / BK;
    unsigned voffA[2], voffB[2];
#pragma unroll
    for (int i = 0; i < 2; ++i) { int R, C; stage_rc(tid * 16 + i * 8192, R, C); const int Rb = Epi::PERM ? ((R & ~31) + perm32(R & 31)) : R;
        voffA[i] = (unsigned)(R * g.lda + C) * 2u; voffB[i] = (unsigned)(Rb * K + C) * 2u; }
    const size_t kstep = (size_t)(BK * 2);
    const size_t hstepB = (size_t)HALF * K * 2, hstepA = (size_t)HALF * g.lda * 2;
    const size_t tstepB = 2 * hstepB, tstepA = 2 * hstepA;
    const unsigned ldsw = (unsigned)wid * 1024u;
    const int aoff = lds_byte(wr * 64 + fr, fq * 8), boff = lds_byte(wc * 32 + fr, fq * 8);
#define PG8_SA(b, h) (((b) * 2 + (h)) * HTB)
#define PG8_SB(b, h) ((4 + (b) * 2 + (h)) * HTB)
#define PG8_STAGE(bufoff, gbase, voff) do { _Pragma("unroll") for (int _i = 0; _i < 2; ++_i) \
        __builtin_amdgcn_global_load_lds((const unsigned*)((const char*)(gbase) + (voff)[_i]), (PG8_LAS unsigned*)(lds + (bufoff) + ldsw + _i * 8192), 16, 0, 0); } while (0)
#define PG8_LDA(dst, b, h) do { _Pragma("unroll") for (int m = 0; m < 4; ++m) _Pragma("unroll") for (int k = 0; k < 2; ++k) dst[m][k] = *(const PG8_LAS bf16x8*)(lds + PG8_SA(b, h) + aoff + m * 2048 + k * 1024); } while (0)
#define PG8_LDB(dst, b, h) do { _Pragma("unroll") for (int n = 0; n < 2; ++n) _Pragma("unroll") for (int k = 0; k < 2; ++k) dst[n][k] = *(const PG8_LAS bf16x8*)(lds + PG8_SB(b, h) + boff + n * 2048 + k * 1024); } while (0)
#define PG8_MMA(ai, bj, At, Bt) do { __builtin_amdgcn_s_setprio(1); _Pragma("unroll") for (int m = 0; m < 4; ++m) _Pragma("unroll") for (int n = 0; n < 2; ++n) _Pragma("unroll") for (int k = 0; k < 2; ++k) \
        acc[ai][bj][m][n] = __builtin_amdgcn_mfma_f32_16x16x32_bf16(Bt[n][k], At[m][k], acc[ai][bj][m][n], 0, 0, 0); __builtin_amdgcn_s_setprio(0); } while (0)
#define PG8_WAIT_V(n) asm volatile("s_waitcnt vmcnt(" #n ")" ::: "memory")
#define PG8_WAIT_L(n) asm volatile("s_waitcnt lgkmcnt(" #n ")" ::: "memory")
#define PG8_BAR __builtin_amdgcn_s_barrier()
#define PG8_SCHED __builtin_amdgcn_sched_barrier(0)
    Unit cur, nxt; int ui = 0;
    if (!S.next(0, cur)) return;
    f32x4 acc[2][2][4][2];
#pragma unroll
    for (int a = 0; a < 2; ++a)
#pragma unroll
        for (int b = 0; b < 2; ++b)
#pragma unroll
            for (int m = 0; m < 4; ++m)
#pragma unroll
                for (int n = 0; n < 2; ++n) acc[a][b][m][n] = (f32x4){0.f, 0.f, 0.f, 0.f};
    bf16x8 At[4][2], B0[2][2], B1[2][2];
    const char* cA = (const char*)g.A + (size_t)cur.pm * tstepA; const char* cB = (const char*)g.Bt + (size_t)cur.pn * tstepB;
    S.a_ready(cur);
    if constexpr (SP2) {
        PG8_STAGE(PG8_SB(0, 0), cB, voffB); PG8_STAGE(PG8_SB(0, 1), cB + hstepB, voffB); PG8_STAGE(PG8_SA(0, 0), cA, voffA); PG8_STAGE(PG8_SA(0, 1), cA + hstepA, voffA);
        if (wr == 1) PG8_BAR;
        PG8_WAIT_V(2); PG8_BAR;
        PG8_STAGE(PG8_SB(1, 0), cB + kstep, voffB); PG8_STAGE(PG8_SA(1, 0), cA + kstep, voffA); PG8_STAGE(PG8_SB(1, 1), cB + hstepB + kstep, voffB);
        PG8_WAIT_V(6); PG8_BAR;
    } else {
        PG8_STAGE(PG8_SB(0, 0), cB, voffB); PG8_STAGE(PG8_SA(0, 0), cA, voffA); PG8_STAGE(PG8_SB(0, 1), cB + hstepB, voffB); PG8_STAGE(PG8_SA(0, 1), cA + hstepA, voffA);
        if (wr == 1) PG8_BAR;
        PG8_WAIT_V(4); PG8_BAR;
        PG8_STAGE(PG8_SB(1, 0), cB + kstep, voffB); PG8_STAGE(PG8_SA(1, 0), cA + kstep, voffA); PG8_STAGE(PG8_SB(1, 1), cB + hstepB + kstep, voffB);
        PG8_WAIT_V(6); PG8_BAR;
    }
    for (;;) {
        const bool has_next = S.next(ui + 1, nxt);
        const char* nA = has_next ? (const char*)g.A + (size_t)nxt.pm * tstepA : cA; const char* nB = has_next ? (const char*)g.Bt + (size_t)nxt.pn * tstepB : cB;
        for (int t = 0; t < nt; t += 2) {
            const bool last = (t == nt - 2);
            const char* a1 = cA + (size_t)(t + 1) * kstep;
            const char* a2 = last ? nA : cA + (size_t)(t + 2) * kstep; const char* b2 = last ? nB : cB + (size_t)(t + 2) * kstep;
            const char* a3 = a2 + kstep; const char* b3 = b2 + kstep;
            if (last && has_next) S.a_ready(nxt);
            if constexpr (SP2) {
            PG8_LDB(B0, 0, 0); PG8_LDB(B1, 0, 1); PG8_SCHED; PG8_LDA(At, 0, 0); PG8_STAGE(PG8_SA(1, 1), a1 + hstepA, voffA);
            PG8_WAIT_V(8); PG8_WAIT_L(0); PG8_BAR; PG8_MMA(0, 0, At, B0); PG8_MMA(0, 1, At, B1); PG8_BAR; PG8_SCHED;
            PG8_LDA(At, 0, 1); PG8_STAGE(PG8_SB(0, 0), b2, voffB); PG8_STAGE(PG8_SB(0, 1), b2 + hstepB, voffB); PG8_STAGE(PG8_SA(0, 0), a2, voffA);
            PG8_WAIT_V(8); PG8_WAIT_L(0); PG8_BAR; PG8_MMA(1, 0, At, B0); PG8_MMA(1, 1, At, B1); PG8_BAR; PG8_SCHED;
            PG8_LDB(B0, 1, 0); PG8_LDB(B1, 1, 1); PG8_SCHED; PG8_LDA(At, 1, 0); PG8_STAGE(PG8_SA(0, 1), a2 + hstepA, voffA);
            PG8_WAIT_V(8); PG8_WAIT_L(0); PG8_BAR; PG8_MMA(0, 0, At, B0); PG8_MMA(0, 1, At, B1); PG8_BAR; PG8_SCHED;
            PG8_LDA(At, 1, 1); PG8_STAGE(PG8_SB(1, 0), b3, voffB); PG8_STAGE(PG8_SB(1, 1), b3 + hstepB, voffB); PG8_STAGE(PG8_SA(1, 0), a3, voffA);
            PG8_WAIT_V(8); PG8_WAIT_L(0); PG8_BAR; PG8_MMA(1, 0, At, B0); PG8_MMA(1, 1, At, B1); PG8_BAR; PG8_SCHED;
            } else {
            PG8_LDB(B0, 0, 0); PG8_SCHED; PG8_LDA(At, 0, 0); PG8_STAGE(PG8_SA(1, 1), a1 + hstepA, voffA);
            PG8_WAIT_L(8); PG8_BAR; PG8_WAIT_L(0); PG8_MMA(0, 0, At, B0); PG8_BAR; PG8_SCHED;
            PG8_LDB(B1, 0, 1); PG8_STAGE(PG8_SB(0, 0), b2, voffB);
            PG8_BAR; PG8_WAIT_L(0); PG8_MMA(0, 1, At, B1); PG8_BAR;
            PG8_LDA(At, 0, 1); PG8_STAGE(PG8_SA(0, 0), a2, voffA);
            PG8_BAR; PG8_WAIT_L(0); PG8_MMA(1, 0, At, B0); PG8_BAR; PG8_SCHED;
            PG8_STAGE(PG8_SB(0, 1), b2 + hstepB, voffB);
            PG8_WAIT_V(6); PG8_BAR; PG8_MMA(1, 1, At, B1); PG8_BAR;
            PG8_LDB(B0, 1, 0); PG8_SCHED; PG8_LDA(At, 1, 0); PG8_STAGE(PG8_SA(0, 1), a2 + hstepA, voffA);
            PG8_WAIT_L(8); PG8_BAR; PG8_WAIT_L(0); PG8_MMA(0, 0, At, B0); PG8_BAR; PG8_SCHED;
            PG8_LDB(B1, 1, 1); PG8_STAGE(PG8_SB(1, 0), b3, voffB);
            PG8_BAR; PG8_WAIT_L(0); PG8_MMA(0, 1, At, B1); PG8_BAR;
            PG8_LDA(At, 1, 1); PG8_STAGE(PG8_SA(1, 0), a3, voffA);
            PG8_BAR; PG8_WAIT_L(0); PG8_MMA(1, 0, At, B0); PG8_BAR; PG8_SCHED;
            PG8_STAGE(PG8_SB(1, 1), b3 + hstepB, voffB);
            PG8_WAIT_V(6); PG8_BAR; PG8_MMA(1, 1, At, B1); PG8_BAR;
            }
        }
        if constexpr (ALIGN_EPI) { if (wr == 0) PG8_BAR; }
        if constexpr (!Epi::AFTER_DRAIN) { E(acc, cur, wr, wc, fr, fq); S.done(cur); }
        if (!has_next) break;
#pragma unroll
        for (int a = 0; a < 2; ++a)
#pragma unroll
            for (int b = 0; b < 2; ++b)
#pragma unroll
                for (int m = 0; m < 4; ++m)
#pragma unroll
                    for (int n = 0; n < 2; ++n) acc[a][b][m][n] = (f32x4){0.f, 0.f, 0.f, 0.f};
        cur = nxt; cA = nA; cB = nB; ++ui;
        if constexpr (ALIGN_EPI) { if (wr == 1) PG8_BAR; }
    }
    PG8_WAIT_V(0);
    if constexpr (!ALIGN_EPI) { if (wr == 0) PG8_BAR; }
    PG8_BAR;
    if constexpr (Epi::AFTER_DRAIN) { E.fused(acc, cur, wr, wc, fr, fq, lds, wid, lane); S.done(cur); }
#undef PG8_SA
#undef PG8_SB
#undef PG8_STAGE
#undef PG8_LDA
#undef PG8_LDB
#undef PG8_MMA
#undef PG8_WAIT_V
#undef PG8_WAIT_L
#undef PG8_BAR
#undef PG8_SCHED
}
}
#ifndef PG8_SP2
#define PG8_SP2 true
#endif
#ifndef PG8_ALIGN
#define PG8_ALIGN true
#endif
#define LAS __attribute__((address_space(3)))
#define DI __device__ __forceinline__
typedef unsigned short bf16;
typedef short bf16x8 __attribute__((ext_vector_type(8)));
typedef float f32x4 __attribute__((ext_vector_type(4)));
typedef unsigned u32x4 __attribute__((ext_vector_type(4)));
typedef unsigned u32x2 __attribute__((ext_vector_type(2)));
typedef float f32x2_t __attribute__((ext_vector_type(2)));
typedef __bf16 bf16x2_t __attribute__((ext_vector_type(2)));
typedef unsigned long long u64;

constexpr int S = 16384, D = 1024, DFF = 2816, NH = 16, HD = 64;
constexpr int NWAVES = 8, NTHR = 512;
constexpr float ALPHA_F = 1.681792830507429f;
constexpr float QSCALE = 0.125f * 1.4426950408889634f;
constexpr float LN_EPS = 1e-5f;
constexpr int LDS_BYTES = 147456;

constexpr size_t MiB = 1u << 20;
constexpr size_t WS_TAB = 1 * MiB;
constexpr size_t WS_BIAS = 2 * MiB;
constexpr size_t WS_KMEAN = 2 * MiB + 65536;
constexpr size_t WS_WA = 4 * MiB;
constexpr size_t WS_WVT = WS_WA + 4608 * 1024;
constexpr size_t WS_WO = WS_WVT + 2 * MiB;
constexpr size_t WS_WC1 = WS_WO + 2 * MiB;
constexpr size_t WS_WC2 = WS_WC1 + 2 * MiB;
constexpr size_t WS_WGU = WS_WC2 + 65536;
constexpr size_t WS_WD = WS_WGU + 11 * MiB;
static_assert(WS_WD + 5767168 <= 32 * MiB, "weights region");
constexpr size_t WS_XB = 32 * MiB;
constexpr size_t WS_ACT = 64 * MiB;
constexpr size_t WS_Q = WS_ACT;
constexpr size_t WS_O = WS_ACT + 32 * MiB;
constexpr size_t WS_KVC = WS_ACT + 64 * MiB;
constexpr size_t WS_KSEL = WS_KVC + 17 * MiB;
constexpr size_t WS_KWIN = WS_KSEL + 8 * MiB;
constexpr size_t WS_VSELT = WS_KWIN + 8 * MiB;
constexpr size_t WS_GATES = WS_VSELT + 16 * MiB;
constexpr size_t WS_HC = WS_GATES + 3 * MiB;
constexpr size_t WS_KC = WS_HC + 4 * MiB;
constexpr size_t WS_VCT = WS_KC + 512 * 1024;
constexpr size_t WS_MK = WS_ACT + 64 * MiB;
constexpr size_t WS_MVT = WS_MK + 32 * MiB;
constexpr size_t WS_H = WS_ACT;
constexpr size_t WS_END = 256 * MiB;
static_assert(WS_VCT + 512 * 1024 <= WS_END && WS_MVT + 32 * MiB <= WS_END && WS_H + (size_t)S * DFF * 2 <= WS_END, "ws map");

DI unsigned cvtpk(float lo, float hi) { f32x2_t v = {lo, hi}; bf16x2_t b = __builtin_convertvector(v, bf16x2_t); return __builtin_bit_cast(unsigned, b); }
DI int lane_id() { int l; asm volatile("v_mbcnt_lo_u32_b32 %0, -1, 0\n\tv_mbcnt_hi_u32_b32 %0, -1, %0" : "=v"(l)); return l; }
DI float ex2(float x) { return __builtin_amdgcn_exp2f(x); }
DI bf16x8 ldg8(const bf16* p) { return *(const bf16x8*)p; }
#define MFMA16(a, b, c) __builtin_amdgcn_mfma_f32_16x16x32_bf16((a), (b), (c), 0, 0, 0)
#define LDS_WAIT() asm volatile("s_waitcnt lgkmcnt(0)" ::: "memory")
DI float wave_sum(float v) {
#pragma unroll
    for (int o = 1; o < 64; o <<= 1) v += __shfl_xor(v, o);
    return v;
}

#define XB_TMO      128
#define XB_XCNT(j)  (256  + 64 * (j))
#define XB_XSUB(j)  (1280 + 64 * (j))
#define XB_XGEN(j)  (2304 + 64 * (j))
#define XB_TOP      3328
#define XB_TOPGEN   3392
#define XCD_BAR_WORDS 3456
#define XB_SPIN_CAP (1u << 18)

__device__ __forceinline__ unsigned xb_ld(unsigned* p)              { return __hip_atomic_load(p, __ATOMIC_RELAXED, __HIP_MEMORY_SCOPE_AGENT); }
__device__ __forceinline__ unsigned xb_add(unsigned* p, unsigned v) { return __hip_atomic_fetch_add(p, v, __ATOMIC_RELAXED, __HIP_MEMORY_SCOPE_AGENT); }
__device__ __forceinline__ unsigned xb_xcc_id() { return (unsigned)__builtin_amdgcn_s_getreg((3 << 11) | 20) & 0xFu; }
#define XB_SPIN(cond, bar) do { unsigned _sp = 0; while (cond) { __builtin_amdgcn_s_sleep(1); \
    if ((++_sp & 255u) == 0u) { if (xb_ld(&(bar)[XB_TMO])) break; if (_sp > XB_SPIN_CAP) { atomicAdd(&(bar)[XB_TMO], 1u); break; } } } } while (0)

struct XcdBarrier {
    bool w0; unsigned* bar; unsigned x;
    volatile LAS unsigned* st;
};

__device__ __forceinline__ XcdBarrier xcd_barrier_post(unsigned* bar, volatile LAS unsigned* st) {
    XcdBarrier b; b.bar = bar; b.x = xb_xcc_id(); b.st = st;
    if (threadIdx.x == 0) (void)xb_add(&bar[XB_XCNT(b.x)], 1u);
    return b;
}
__device__ __forceinline__ void xcd_barrier_complete(unsigned* bar, unsigned x, unsigned& nloc, unsigned& nx) {
    const unsigned G = gridDim.x * gridDim.y * gridDim.z;
    unsigned sum, cnt, mine, sp = 0u;
    for (;;) {
        sum = 0u; cnt = 0u; mine = 0u;
#pragma unroll
        for (unsigned j = 0; j < 16; ++j) { const unsigned c = xb_ld(&bar[XB_XCNT(j)]); sum += c; cnt += (c > 0u) ? 1u : 0u; mine = (j == x) ? c : mine; }
        if (sum == G) break;
        __builtin_amdgcn_s_sleep(1);
        if ((++sp & 255u) == 0u) { if (xb_ld(&bar[XB_TMO])) break; if (sp > XB_SPIN_CAP) { atomicAdd(&bar[XB_TMO], 1u); break; } }
    }
    nloc = mine > 0u ? mine : 1u; nx = cnt > 0u ? cnt : 1u;
}

__device__ __forceinline__ void xcd_barrier(const XcdBarrier& b) {
    asm volatile("s_waitcnt vmcnt(0)" ::: "memory");
    __syncthreads();
    if (b.w0 && lane_id() == 0) {
        unsigned* bar = b.bar;
        __builtin_amdgcn_s_waitcnt(0);
        unsigned nloc = b.st[0], nx = b.st[1];
        if (nloc == 0u) { xcd_barrier_complete(bar, b.x, nloc, nx); b.st[0] = nloc; b.st[1] = nx; }
        const unsigned old = xb_add(&bar[XB_XSUB(b.x)], 1u);
        const unsigned gen = old / nloc;
        if (old + 1u == (gen + 1u) * nloc) {
            __builtin_amdgcn_fence(__ATOMIC_RELEASE, "agent");
            asm volatile("s_waitcnt vmcnt(0)" ::: "memory");
            const unsigned og = xb_add(&bar[XB_TOP], 1u);
            const unsigned tg = og / nx;
            if (og + 1u == (tg + 1u) * nx) xb_add(&bar[XB_TOPGEN], 1u);
            else XB_SPIN(xb_ld(&bar[XB_TOPGEN]) == tg, bar);
            __builtin_amdgcn_fence(__ATOMIC_ACQUIRE, "agent");
            xb_add(&bar[XB_XGEN(b.x)], 1u);
            asm volatile("s_waitcnt vmcnt(0)" ::: "memory");
        } else {
            XB_SPIN(xb_ld(&bar[XB_XGEN(b.x)]) == gen, bar);
            __builtin_amdgcn_fence(__ATOMIC_ACQUIRE, "agent");
            asm volatile("s_waitcnt vmcnt(0)" ::: "memory");
        }
    }
    __syncthreads();
}


struct Args { const float* in[19]; const int* pos; float* out; unsigned char* ws; };

struct CmpOrder {
    int G, c;
    __device__ bool next(int i, pg8::Unit& u) const { const int L = i * G + c; if (L >= 32) return false; u.pm = L; u.pn = L >> 4; return true; }
    DI void a_ready(const pg8::Unit&) const {}
    DI void done(const pg8::Unit&) const {}
};

DI void rope8(float (&v)[8], const float* tabrow, int fq) {
    float p[8];
#pragma unroll
    for (int i = 0; i < 8; ++i) p[i] = __shfl_xor(v[i], 16);
    if (fq < 2) {
        const f32x4 c0 = *(const f32x4*)(tabrow), c1 = *(const f32x4*)(tabrow + 4), s0 = *(const f32x4*)(tabrow + 8), s1 = *(const f32x4*)(tabrow + 12);
        const float cs[8] = {c0[0], c0[1], c0[2], c0[3], c1[0], c1[1], c1[2], c1[3]};
        const float sn[8] = {s0[0], s0[1], s0[2], s0[3], s1[0], s1[1], s1[2], s1[3]};
#pragma unroll
        for (int i = 0; i < 8; ++i) v[i] = (fq == 0) ? (v[i] * cs[i] - p[i] * sn[i]) : (v[i] * cs[i] + p[i] * sn[i]);
    }
}
DI u32x4 pack8(const float (&v)[8]) { u32x4 w; w.x = cvtpk(v[0], v[1]); w.y = cvtpk(v[2], v[3]); w.z = cvtpk(v[4], v[5]); w.w = cvtpk(v[6], v[7]); return w; }

struct EpiNsaA {
    static constexpr bool PERM = true, AFTER_DRAIN = false;
    bf16* q; bf16* kvc; bf16* ksel; bf16* kwin; float* gates; const float* tab;
    DI void operator()(const f32x4 (&acc)[2][2][4][2], const pg8::Unit& u, int wr, int wc, int fr, int fq) const {
        const int pn = u.pn;
        const bool rope = (pn != 7) && (pn != 8) && ((wc & 1) == 0);
#pragma unroll
        for (int ai = 0; ai < 2; ++ai)
#pragma unroll
            for (int m = 0; m < 4; ++m) {
                const int row = u.pm * 256 + ai * 128 + wr * 64 + m * 16 + fr;
#pragma unroll
                for (int bj = 0; bj < 2; ++bj) {
                    const int cb = bj * 128 + wc * 32 + 8 * fq;
                    float v[8];
#pragma unroll
                    for (int i = 0; i < 4; ++i) { v[i] = acc[ai][bj][m][0][i]; v[4 + i] = acc[ai][bj][m][1][i]; }
                    if (pn == 8) {
                        if (cb < 48) {
#pragma unroll
                            for (int i = 0; i < 8; ++i) v[i] = 1.0f / (1.0f + __expf(-v[i]));
                            float* gp = gates + (size_t)row * 48 + cb;
                            *(f32x4*)gp = (f32x4){v[0], v[1], v[2], v[3]}; *(f32x4*)(gp + 4) = (f32x4){v[4], v[5], v[6], v[7]};
                        }
                        continue;
                    }
                    if (rope) rope8(v, tab + (size_t)row * 16, fq);
                    if (pn < 4) {
#pragma unroll
                        for (int i = 0; i < 8; ++i) v[i] *= QSCALE;
                        *(u32x4*)(q + (size_t)row * 1024 + pn * 256 + cb) = pack8(v);
                    } else {
                        bf16* base = (pn == 4) ? kvc : (pn == 5) ? ksel : (pn == 6) ? kwin : (kvc + (size_t)4 * S * 64);
                        const int g = cb >> 6, d = cb & 63;
                        *(u32x4*)(base + ((size_t)g * S + row) * 64 + d) = pack8(v);
                    }
                }
            }
    }
};
struct EpiMobaA {
    static constexpr bool PERM = true, AFTER_DRAIN = false;
    bf16* q; bf16* k; const float* tab;
    DI void operator()(const f32x4 (&acc)[2][2][4][2], const pg8::Unit& u, int wr, int wc, int fr, int fq) const {
        const int pn = u.pn;
        const bool rope = ((wc & 1) == 0);
#pragma unroll
        for (int ai = 0; ai < 2; ++ai)
#pragma unroll
            for (int m = 0; m < 4; ++m) {
                const int row = u.pm * 256 + ai * 128 + wr * 64 + m * 16 + fr;
#pragma unroll
                for (int bj = 0; bj < 2; ++bj) {
                    const int cb = bj * 128 + wc * 32 + 8 * fq;
                    float v[8];
#pragma unroll
                    for (int i = 0; i < 4; ++i) { v[i] = acc[ai][bj][m][0][i]; v[4 + i] = acc[ai][bj][m][1][i]; }
                    if (rope) rope8(v, tab + (size_t)row * 16, fq);
                    if (pn < 4) {
#pragma unroll
                        for (int i = 0; i < 8; ++i) v[i] *= QSCALE;
                        *(u32x4*)(q + (size_t)row * 1024 + pn * 256 + cb) = pack8(v);
                    } else {
                        const int h = (pn - 4) * 4 + (cb >> 6), d = cb & 63;
                        *(u32x4*)(k + ((size_t)h * S + row) * 64 + d) = pack8(v);
                    }
                }
            }
    }
};
DI float gelu_tanh(float x) {
    const float u = 0.7978845608028654f * (x + 0.044715f * x * x * x);
    const float e = __expf(2.0f * u);
    const float t = 1.0f - 2.0f / (e + 1.0f);
    return 0.5f * x * (1.0f + t);
}
struct EpiCmp1 {
    static constexpr bool PERM = true, AFTER_DRAIN = false;
    bf16* H; const float* bias;
    DI void operator()(const f32x4 (&acc)[2][2][4][2], const pg8::Unit& u, int wr, int wc, int fr, int fq) const {
        const float* bb = bias + u.pn * 256;
#pragma unroll
        for (int ai = 0; ai < 2; ++ai)
#pragma unroll
            for (int m = 0; m < 4; ++m) {
                const int row = u.pm * 256 + ai * 128 + wr * 64 + m * 16 + fr;
#pragma unroll
                for (int bj = 0; bj < 2; ++bj) {
                    const int cb = bj * 128 + wc * 32 + 8 * fq;
                    const f32x4 b0 = *(const f32x4*)(bb + cb), b1 = *(const f32x4*)(bb + cb + 4);
                    float v[8];
#pragma unroll
                    for (int i = 0; i < 4; ++i) { v[i] = gelu_tanh(acc[ai][bj][m][0][i] + b0[i]); v[4 + i] = gelu_tanh(acc[ai][bj][m][1][i] + b1[i]); }
                    *(u32x4*)(H + (size_t)row * 256 + cb) = pack8(v);
                }
            }
    }
};
struct EpiResid {
    static constexpr bool PERM = false, AFTER_DRAIN = false;
    float* x;
    DI void operator()(const f32x4 (&acc)[2][2][4][2], const pg8::Unit& u, int wr, int wc, int fr, int fq) const {
#pragma unroll
        for (int ai = 0; ai < 2; ++ai)
#pragma unroll
            for (int m = 0; m < 4; ++m) {
                const int row = u.pm * 256 + ai * 128 + wr * 64 + m * 16 + fr;
                float* rp = x + (size_t)row * D + u.pn * 256 + wc * 32 + 4 * fq;
#pragma unroll
                for (int bj = 0; bj < 2; ++bj)
#pragma unroll
                    for (int n = 0; n < 2; ++n) {
                        f32x4* p = (f32x4*)(rp + bj * 128 + n * 16);
                        const f32x4 o = *p;
                        *p = o * ALPHA_F + acc[ai][bj][m][n];
                    }
            }
    }
};
struct EpiSwiglu {
    static constexpr bool PERM = true, AFTER_DRAIN = false;
    bf16* h;
    DI void operator()(const f32x4 (&acc)[2][2][4][2], const pg8::Unit& u, int wr, int wc, int fr, int fq) const {
#pragma unroll
        for (int ai = 0; ai < 2; ++ai)
#pragma unroll
            for (int m = 0; m < 4; ++m) {
                const int row = u.pm * 256 + ai * 128 + wr * 64 + m * 16 + fr;
                float v[8];
#pragma unroll
                for (int n = 0; n < 2; ++n)
#pragma unroll
                    for (int i = 0; i < 4; ++i) { const float g = acc[ai][0][m][n][i], uu = acc[ai][1][m][n][i]; v[4 * n + i] = g / (1.0f + __expf(-g)) * uu; }
                *(u32x4*)(h + (size_t)row * DFF + u.pn * 128 + wc * 32 + 8 * fq) = pack8(v);
            }
    }
};

DI void transpose_item(const float* W, int ldw, int ncols, bf16* WT, int ldt, int ilv, LAS float* scr, int item, int lane) {
    const int nblk = (ncols + 31) >> 5, kb = item / nblk, nb = item % nblk, k0 = 64 * kb, n0 = 32 * nb;
    const int cl = lane & 31; const bool cv = (n0 + cl) < ncols;
#pragma unroll 8
    for (int i = 0; i < 32; ++i) { const int kk = 2 * i + (lane >> 5); scr[kk * 33 + cl] = cv ? W[(size_t)(k0 + kk) * ldw + n0 + cl] : 0.f; }
    LDS_WAIT();
    const int c = lane & 7;
#pragma unroll
    for (int j = 0; j < 4; ++j) { const int n = (lane >> 3) + 8 * j; const LAS float* s = scr + (8 * c) * 33 + n;
        u32x4 o; o.x = cvtpk(s[0 * 33], s[1 * 33]); o.y = cvtpk(s[2 * 33], s[3 * 33]); o.z = cvtpk(s[4 * 33], s[5 * 33]); o.w = cvtpk(s[6 * 33], s[7 * 33]);
        const int ns = n0 + n; const int dr = ilv ? ((ns >> 7) * 256 + (ns & 127)) : ns;
        if (ns < ncols) *(u32x4*)(WT + (size_t)dr * ldt + k0 + 8 * c) = o; }
    LDS_WAIT();
}
struct ConvCtx { LAS float* scr; int gw, NGW, lane, base; };
DI void conv_job(ConvCtx& c, const float* W, int ldw, int K, int ncols, bf16* WT, int ldt, int ilv) {
    const int ni = (K / 64) * ((ncols + 31) >> 5);
    int first = c.gw - (c.base % c.NGW); if (first < 0) first += c.NGW;
    for (int it = first; it < ni; it += c.NGW) transpose_item(W, ldw, ncols, WT, ldt, ilv, c.scr, it, c.lane);
    c.base += ni;
}

DI void ln_row(float* xrow, bf16* brow, const float* gam, const float* bet, int lane) {
    f32x4* xr = (f32x4*)xrow + lane;
    f32x4 v[4]; float s = 0.f;
#pragma unroll
    for (int j = 0; j < 4; ++j) { v[j] = xr[64 * j]; s += (v[j][0] + v[j][1]) + (v[j][2] + v[j][3]); }
    const float mean = wave_sum(s) * (1.f / D); float s2 = 0.f;
#pragma unroll
    for (int j = 0; j < 4; ++j) { v[j] = v[j] - mean; s2 += (v[j][0] * v[j][0] + v[j][1] * v[j][1]) + (v[j][2] * v[j][2] + v[j][3] * v[j][3]); }
    const float rstd = 1.0f / sqrtf(wave_sum(s2) * (1.f / D) + LN_EPS);
#pragma unroll
    for (int j = 0; j < 4; ++j) {
        const f32x4 g = *((const f32x4*)gam + lane + 64 * j), b = *((const f32x4*)bet + lane + 64 * j);
        const f32x4 o = v[j] * rstd * g + b;
        xr[64 * j] = o;
        u32x2 w; w.x = cvtpk(o[0], o[1]); w.y = cvtpk(o[2], o[3]);
        *((u32x2*)brow + lane + 64 * j) = w;
    }
}

DI void sincos_d(double r, float& sn, float& cs) {
    const double z = r * r;
    double s = 1.0 / 15511210043330985984000000.0;
    s = s * z - 1.0 / 25852016738884976640000.0;
    s = s * z + 1.0 / 51090942171709440000.0;
    s = s * z - 1.0 / 121645100408832000.0;
    s = s * z + 1.0 / 355687428096000.0;
    s = s * z - 1.0 / 1307674368000.0;
    s = s * z + 1.0 / 6227020800.0;
    s = s * z - 1.0 / 39916800.0;
    s = s * z + 1.0 / 362880.0;
    s = s * z - 1.0 / 5040.0;
    s = s * z + 1.0 / 120.0;
    s = s * z - 1.0 / 6.0;
    s = s * z + 1.0;
    sn = (float)(s * r);
    double c = 1.0 / 620448401733239439360000.0;
    c = c * z - 1.0 / 1124000727777607680000.0;
    c = c * z + 1.0 / 2432902008176640000.0;
    c = c * z - 1.0 / 6402373705728000.0;
    c = c * z + 1.0 / 20922789888000.0;
    c = c * z - 1.0 / 87178291200.0;
    c = c * z + 1.0 / 479001600.0;
    c = c * z - 1.0 / 3628800.0;
    c = c * z + 1.0 / 40320.0;
    c = c * z - 1.0 / 720.0;
    c = c * z + 1.0 / 24.0;
    c = c * z - 0.5;
    c = c * z + 1.0;
    cs = (float)c;
}

DI float kg_allmax(float x) {
    auto r = __builtin_amdgcn_permlane16_swap(__float_as_uint(x), __float_as_uint(x), false, false);
    x = fmaxf(__uint_as_float(r[0]), __uint_as_float(r[1]));
    auto q = __builtin_amdgcn_permlane32_swap(__float_as_uint(x), __float_as_uint(x), false, false);
    return fmaxf(__uint_as_float(q[0]), __uint_as_float(q[1]));
}
DI float kg_allsum(float x) {
    auto r = __builtin_amdgcn_permlane16_swap(__float_as_uint(x), __float_as_uint(x), false, false);
    x = __uint_as_float(r[0]) + __uint_as_float(r[1]);
    auto q = __builtin_amdgcn_permlane32_swap(__float_as_uint(x), __float_as_uint(x), false, false);
    return __uint_as_float(q[0]) + __uint_as_float(q[1]);
}
template <int CTRL> DI float dppf(float v) { return __int_as_float(__builtin_amdgcn_update_dpp(0, __float_as_int(v), CTRL, 0xf, 0xf, true)); }
template <int CTRL> DI unsigned dppu(unsigned v) { return (unsigned)__builtin_amdgcn_update_dpp(0, (int)v, CTRL, 0xf, 0xf, true); }
DI float quad_sum(float v) { v += dppf<0xB1>(v); v += dppf<0x4E>(v); return v; }
DI float wave_allmax_f(float v) {
    v = fmaxf(v, dppf<0xB1>(v)); v = fmaxf(v, dppf<0x4E>(v)); v = fmaxf(v, dppf<0x141>(v)); v = fmaxf(v, dppf<0x140>(v));
    return kg_allmax(v);
}
DI unsigned wave_allmin_u(unsigned v) {
    v = min(v, dppu<0xB1>(v)); v = min(v, dppu<0x4E>(v)); v = min(v, dppu<0x141>(v)); v = min(v, dppu<0x140>(v));
    auto r = __builtin_amdgcn_permlane16_swap(v, v, false, false); v = min(r[0], r[1]);
    auto q = __builtin_amdgcn_permlane32_swap(v, v, false, false); return min(q[0], q[1]);
}
DI f32x4 sm_init(float m, bool colsel) { const float b = (m < -1e29f) ? 0.f : m; const float v = colsel ? -b : -INFINITY; return (f32x4){v, v, v, v}; }
DI bf16x8 sm_step(f32x4 s0, f32x4 s1, float& m, float& l, f32x4 (&O)[4]) {
    const float mx = fmaxf(fmaxf(fmaxf(s0[0], s0[1]), fmaxf(s0[2], s0[3])), fmaxf(fmaxf(s1[0], s1[1]), fmaxf(s1[2], s1[3])));
    const bool fresh = m < -1e29f;
    const bool trig = (mx > 8.f) || (fresh && mx > -INFINITY);
    if (__ballot(trig) != 0ull) {
        const float mxa = kg_allmax(mx);
        const bool none = !(mxa > -INFINITY);
        float mn = fresh ? mxa : fmaxf(mxa, 0.f);
        mn = (fresh && none) ? 0.f : mn;
        const float alpha = fresh ? 1.f : ex2(-mn);
        m = (fresh && none) ? m : ((fresh ? 0.f : m) + mn);
        l *= alpha;
#pragma unroll
        for (int dt = 0; dt < 4; ++dt) O[dt] = O[dt] * alpha;
#pragma unroll
        for (int i = 0; i < 4; ++i) { s0[i] -= mn; s1[i] -= mn; }
    }
    float p[8];
#pragma unroll
    for (int i = 0; i < 4; ++i) { p[i] = ex2(s0[i]); p[4 + i] = ex2(s1[i]); }
    l += ((p[0] + p[1]) + (p[2] + p[3])) + ((p[4] + p[5]) + (p[6] + p[7]));
    u32x4 w; w.x = cvtpk(p[0], p[1]); w.y = cvtpk(p[2], p[3]); w.z = cvtpk(p[4], p[5]); w.w = cvtpk(p[6], p[7]);
    return __builtin_bit_cast(bf16x8, w);
}
DI void load_k(bf16x8 (&kA)[2][2], const bf16* K, int key0, int fr, int kg) {
    const bf16* p = K + (size_t)(key0 + 8 * (fr >> 2) + (fr & 3)) * 64 + 8 * kg;
    kA[0][0] = ldg8(p); kA[0][1] = ldg8(p + 32); kA[1][0] = ldg8(p + 4 * 64); kA[1][1] = ldg8(p + 4 * 64 + 32);
}
DI void load_vt(bf16x8 (&vA)[4], const bf16* VT, size_t ldv, int key0, int fr, int kg) {
    const bf16* p = VT + (size_t)fr * ldv + key0 + 8 * kg;
#pragma unroll
    for (int dt = 0; dt < 4; ++dt) vA[dt] = ldg8(p + (size_t)(16 * dt) * ldv);
}
DI void qk(f32x4& s0, f32x4& s1, const bf16x8 (&kA)[2][2], const bf16x8 (&qB)[2], const f32x4 z = {0.f, 0.f, 0.f, 0.f}) {
    s0 = MFMA16(kA[0][0], qB[0], z); s0 = MFMA16(kA[0][1], qB[1], s0);
    s1 = MFMA16(kA[1][0], qB[0], z); s1 = MFMA16(kA[1][1], qB[1], s1);
}


DI void gload_lds16(const bf16* g, LAS unsigned char* l) { __builtin_amdgcn_global_load_lds((const unsigned*)g, (LAS unsigned*)l, 16, 0, 0); }
DI void stage_chunk(LAS unsigned char* buf, const bf16* K, const bf16* VT, size_t ldv, int key0, int w, int lane) {
    const int b = 16 * lane, swz = b ^ (((b >> 9) & 1) << 5), rr = swz >> 6, cc = (swz & 63) >> 1;
    const int kb = key0 + 32 * w;
    LAS unsigned char* dst = buf + w * 8192;
    const bf16* kp = K + (size_t)(kb + 8 * (rr >> 2) + (rr & 3)) * 64 + cc;
    gload_lds16(kp, dst); gload_lds16(kp + 32, dst + 1024); gload_lds16(kp + 4 * 64, dst + 2048); gload_lds16(kp + 4 * 64 + 32, dst + 3072);
    const bf16* vp = VT + (size_t)rr * ldv + kb + cc;
#pragma unroll
    for (int dt = 0; dt < 4; ++dt) gload_lds16(vp + (size_t)(16 * dt) * ldv, dst + 4096 + dt * 1024);
}
DI int lds_roff(int fr, int kg) { const int ob = fr * 64 + kg * 16; return ob ^ (((ob >> 9) & 1) << 5); }
DI void lds_k(bf16x8 (&kA)[2][2], const LAS unsigned char* stp, int roff) {
    kA[0][0] = *(const LAS bf16x8*)(stp + roff); kA[0][1] = *(const LAS bf16x8*)(stp + 1024 + roff);
    kA[1][0] = *(const LAS bf16x8*)(stp + 2048 + roff); kA[1][1] = *(const LAS bf16x8*)(stp + 3072 + roff);
}
DI void lds_v(bf16x8 (&vA)[4], const LAS unsigned char* stp, int roff) {
#pragma unroll
    for (int dt = 0; dt < 4; ++dt) vA[dt] = *(const LAS bf16x8*)(stp + 4096 + dt * 1024 + roff);
}
#define VM_WAIT0() asm volatile("s_waitcnt vmcnt(0)" ::: "memory")

struct NsaT { const bf16* q; const bf16* ksel; const bf16* kwin; const bf16* vselT; const bf16* vwinT; const bf16* kc; const bf16* vcT; const float* gates; bf16* o; f32x4* park; };

DI void nsa_unit(const NsaT& A, LAS unsigned char* lds, int T, int g, int w, int lane_in) {
    int lane = lane_id(); (void)lane_in;
    const int fr = lane & 15, kg = lane >> 4;
    const int t0 = T * 128 + w * 16;
    const int blk = t0 >> 6;
    LAS float* imp = (LAS float*)(lds) + w * 4096;
    LAS unsigned* sb = (LAS unsigned*)(lds + 131072) + w * 128;
    bf16x8 qB[4][2];
    int tqc[4];
    const int head = 4 * g + (fr & 3);
#pragma unroll
    for (int qd = 0; qd < 4; ++qd) {
        tqc[qd] = t0 + 4 * qd + (fr >> 2);
        const bf16* qp = A.q + (size_t)tqc[qd] * 1024 + head * 64 + 8 * kg;
        qB[qd][0] = ldg8(qp); qB[qd][1] = ldg8(qp + 32);
    }
    const f32x4 z4 = {0.f, 0.f, 0.f, 0.f};
    f32x4 Oc[4][4];
#pragma unroll
    for (int a = 0; a < 4; ++a)
#pragma unroll
        for (int b = 0; b < 4; ++b) Oc[a][b] = z4;
    const bf16* kc = A.kc + (size_t)g * 1024 * 64;
    const bf16* vcT = A.vcT + (size_t)g * 64 * 1024;
    const int ncmp = t0 >> 4;
    const int nst = (ncmp + 31) >> 5;
    if (blk > 15) {
#pragma unroll 4
        for (int i = 0; i < 64; ++i) imp[lane + 64 * i] = 0.f;
    }
    if (nst > 0) {
        int ln_ = lane; asm volatile("" : "+v"(ln_)); const int fr = ln_ & 15, kg = ln_ >> 4; (void)fr; (void)kg;
        float m1[4], l1[4]; int lim[4];
#pragma unroll
        for (int qd = 0; qd < 4; ++qd) { m1[qd] = -1e30f; l1[qd] = 0.f; lim[qd] = (tqc[qd] - 31) >> 4; }
#pragma unroll 1
        for (int st = 0; st < nst; ++st) {
            const int n0 = 32 * st;
            bf16x8 kA[2][2]; load_k(kA, kc, n0, fr, kg);
#pragma unroll
            for (int qd = 0; qd < 4; ++qd) {
                f32x4 s0, s1; qk(s0, s1, kA, qB[qd]);
                float mx = -INFINITY;
#pragma unroll
                for (int i = 0; i < 4; ++i) {
                    s0[i] = (n0 + 8 * kg + i <= lim[qd]) ? s0[i] : -INFINITY;
                    s1[i] = (n0 + 8 * kg + 4 + i <= lim[qd]) ? s1[i] : -INFINITY;
                    mx = fmaxf(mx, fmaxf(s0[i], s1[i]));
                }
                const float mn = fmaxf(m1[qd], mx);
                float sum = 0.f;
#pragma unroll
                for (int i = 0; i < 4; ++i) sum += ex2(s0[i] - mn) + ex2(s1[i] - mn);
                l1[qd] = l1[qd] * ex2(m1[qd] - mn) + sum; m1[qd] = mn;
            }
        }
        float inv[4];
#pragma unroll
        for (int qd = 0; qd < 4; ++qd) {
            const float mt = kg_allmax(m1[qd]);
            const float lt = kg_allsum(l1[qd] * ex2(m1[qd] - mt));
            m1[qd] = mt; inv[qd] = lt > 0.f ? 1.0f / lt : 0.f;
        }
        LDS_WAIT();
#pragma unroll 1
        for (int st = 0; st < nst; ++st) {
            const int n0 = 32 * st;
            bf16x8 kA[2][2]; load_k(kA, kc, n0, fr, kg);
            bf16x8 vA[4]; load_vt(vA, vcT, 1024, n0, fr, kg);
#pragma unroll
            for (int qd = 0; qd < 4; ++qd) {
                f32x4 s0, s1; qk(s0, s1, kA, qB[qd]);
                float p[8];
#pragma unroll
                for (int i = 0; i < 4; ++i) {
                    p[i] = (n0 + 8 * kg + i <= lim[qd]) ? ex2(s0[i] - m1[qd]) * inv[qd] : 0.f;
                    p[4 + i] = (n0 + 8 * kg + 4 + i <= lim[qd]) ? ex2(s1[i] - m1[qd]) * inv[qd] : 0.f;
                }
                u32x4 wv; wv.x = cvtpk(p[0], p[1]); wv.y = cvtpk(p[2], p[3]); wv.z = cvtpk(p[4], p[5]); wv.w = cvtpk(p[6], p[7]);
                const bf16x8 P = __builtin_bit_cast(bf16x8, wv);
#pragma unroll
                for (int dt = 0; dt < 4; ++dt) Oc[qd][dt] = MFMA16(vA[dt], P, Oc[qd][dt]);
                if (blk > 15) {
                    float a0 = 2.f * (p[0] + p[1] + p[2]) + p[3], b0 = p[3], a1 = 2.f * (p[4] + p[5] + p[6]) + p[7], b1 = p[7];
                    a0 = quad_sum(a0); b0 = quad_sum(b0); a1 = quad_sum(a1); b1 = quad_sum(b1);
                    if ((fr & 3) == 0) {
                        const int jb = (n0 >> 2) + 2 * kg;
                        LAS float* ip = imp + (4 * qd + (fr >> 2)) * 256 + jb;
                        __hip_atomic_fetch_add(ip, a0, __ATOMIC_RELAXED, __HIP_MEMORY_SCOPE_WORKGROUP);
                        __hip_atomic_fetch_add(ip + 1, b0 + a1, __ATOMIC_RELAXED, __HIP_MEMORY_SCOPE_WORKGROUP);
                        if (jb + 2 < 256) __hip_atomic_fetch_add(ip + 2, b1, __ATOMIC_RELAXED, __HIP_MEMORY_SCOPE_WORKGROUP);
                    }
                }
            }
        }
    }
    LDS_WAIT();
    if (blk <= 15) {
#pragma unroll
        for (int k = 0; k < 2; ++k) { const int idx = lane + 64 * k; sb[idx] = ((idx & 7) == 0) ? ((2u << blk) - 1u) : 0u; }
    } else {
        for (int qi = 0; qi < 16; ++qi) {
            float val[4];
#pragma unroll
            for (int i = 0; i < 4; ++i) { const int j = lane + 64 * i; const float v = imp[qi * 256 + j]; val[i] = (j >= 1 && j <= blk - 2) ? v : -1.0f; }
            unsigned myword = 0u;
#pragma unroll 1
            for (int r = 0; r < 13; ++r) {
                const float vb = wave_allmax_f(fmaxf(fmaxf(val[0], val[1]), fmaxf(val[2], val[3])));
                unsigned jm = 0xffffu;
#pragma unroll
                for (int i = 3; i >= 0; --i) jm = (val[i] == vb) ? (unsigned)(lane + 64 * i) : jm;
                const int js = (int)__builtin_amdgcn_readfirstlane(wave_allmin_u(jm));
#pragma unroll
                for (int i = 0; i < 4; ++i) val[i] = (lane + 64 * i == js) ? -1.0f : val[i];
                if ((js >> 5) == lane) myword |= 1u << (js & 31);
            }
            if (lane < 8) {
                if (lane == 0) myword |= 1u;
                if (((blk - 1) >> 5) == lane) myword |= 1u << ((blk - 1) & 31);
                if ((blk >> 5) == lane) myword |= 1u << (blk & 31);
                sb[qi * 8 + lane] = myword;
            }
        }
    }
    LDS_WAIT();
    f32x4* park = A.park + ((size_t)((T * 4 + g) * 8 + w) * 16) * 64 + lane;
#pragma unroll
    for (int qd = 0; qd < 4; ++qd) {
        const float g0 = A.gates[(size_t)tqc[qd] * 48 + 3 * head];
#pragma unroll
        for (int dt = 0; dt < 4; ++dt) park[(qd * 4 + dt) * 64] = Oc[qd][dt] * g0;
    }
    f32x4 Ob[4][4]; float m2[4], l2[4];
#pragma unroll
    for (int a = 0; a < 4; ++a) { m2[a] = -1e30f; l2[a] = 0.f;
#pragma unroll
        for (int b = 0; b < 4; ++b) Ob[a][b] = z4; }
    __syncthreads();
    {
        int ln_ = lane; asm volatile("" : "+v"(ln_)); const int fr = ln_ & 15, kg = ln_ >> 4;
        const bf16* ks = A.ksel + (size_t)g * S * 64;
        const bf16* vsT = A.vselT + (size_t)g * 64 * S;
        const int nch = ((2 * T + 1) >> 2) + 1;
        const int roff = lds_roff(fr, kg);
        stage_chunk(lds, ks, vsT, S, 0, w, ln_);
        unsigned W = 0u;
#pragma unroll 1
        for (int c = 0; c < nch; ++c) {
            VM_WAIT0(); __syncthreads();
            if (c + 1 < nch) stage_chunk(lds + ((c + 1) & 1) * 65536, ks, vsT, S, 256 * (c + 1), w, ln_);
            const LAS unsigned char* cb = lds + (c & 1) * 65536;
            if ((c & 7) == 0) W = (ln_ < 16) ? sb[ln_ * 8 + (c >> 3)] : 0u;
#pragma unroll 1
            for (int jj = 0; jj < 4; ++jj) {
                const int j = 4 * c + jj;
                if (j > blk) break;
                const unsigned m16 = (unsigned)__ballot((W >> (j & 31)) & 1u);
                if (m16 == 0u) continue;
#pragma unroll 1
                for (int hs = 0; hs < 2; ++hs) {
                    const int key0 = 64 * j + 32 * hs;
                    const LAS unsigned char* stp = cb + (2 * jj + hs) * 8192;
                    bf16x8 kA[2][2]; lds_k(kA, stp, roff);
                    bf16x8 vA[4]; lds_v(vA, stp, roff);
#pragma unroll
                    for (int qd = 0; qd < 4; ++qd) {
                        const unsigned qm = (m16 >> (4 * qd)) & 0xfu;
                        if (qm == 0u) continue;
                        const bool colsel = (qm >> (fr >> 2)) & 1u;
                        f32x4 s0, s1; qk(s0, s1, kA, qB[qd], sm_init(m2[qd], colsel));
                        if (j == blk) {
#pragma unroll
                            for (int i = 0; i < 4; ++i) {
                                s0[i] = (key0 + 8 * kg + i <= tqc[qd]) ? s0[i] : -INFINITY;
                                s1[i] = (key0 + 8 * kg + 4 + i <= tqc[qd]) ? s1[i] : -INFINITY;
                            }
                        }
                        const bf16x8 P = sm_step(s0, s1, m2[qd], l2[qd], Ob[qd]);
#pragma unroll
                        for (int dt = 0; dt < 4; ++dt) Ob[qd][dt] = MFMA16(vA[dt], P, Ob[qd][dt]);
                    }
                }
            }
        }
        __syncthreads();
    }
    float g2w[4];
#pragma unroll
    for (int qd = 0; qd < 4; ++qd) {
        const float* gp = A.gates + (size_t)tqc[qd] * 48 + 3 * head;
        const float g1 = gp[1]; g2w[qd] = gp[2];
        const float lt = kg_allsum(l2[qd]);
        const float c1 = lt > 0.f ? g1 / lt : 0.f;
#pragma unroll
        for (int dt = 0; dt < 4; ++dt) { park[(qd * 4 + dt) * 64] = park[(qd * 4 + dt) * 64] + Ob[qd][dt] * c1; Ob[qd][dt] = z4; }
        m2[qd] = -1e30f; l2[qd] = 0.f;
    }
    {
        int ln_ = lane; asm volatile("" : "+v"(ln_)); const int fr = ln_ & 15, kg = ln_ >> 4; (void)fr; (void)kg;
        const bf16* kw = A.kwin + (size_t)g * S * 64;
        const bf16* vwT = A.vwinT + (size_t)g * 64 * S;
        int klo = t0 - 511; klo = klo < 0 ? 0 : klo; klo &= ~31;
        const int khi = (t0 + 15) & ~31;
#pragma unroll 1
        for (int key0 = klo; key0 <= khi; key0 += 32) {
            bf16x8 kA[2][2]; load_k(kA, kw, key0, fr, kg);
            bf16x8 vA[4]; load_vt(vA, vwT, S, key0, fr, kg);
            const bool needmask = (key0 + 31 > t0) || (key0 < t0 + 15 - 511);
#pragma unroll
            for (int qd = 0; qd < 4; ++qd) {
                f32x4 s0, s1; qk(s0, s1, kA, qB[qd], sm_init(m2[qd], true));
                if (needmask) {
#pragma unroll
                    for (int i = 0; i < 4; ++i) {
                        const int k0 = key0 + 8 * kg + i, k1 = k0 + 4;
                        s0[i] = (k0 <= tqc[qd] && k0 >= tqc[qd] - 511) ? s0[i] : -INFINITY;
                        s1[i] = (k1 <= tqc[qd] && k1 >= tqc[qd] - 511) ? s1[i] : -INFINITY;
                    }
                }
                const bf16x8 P = sm_step(s0, s1, m2[qd], l2[qd], Ob[qd]);
#pragma unroll
                for (int dt = 0; dt < 4; ++dt) Ob[qd][dt] = MFMA16(vA[dt], P, Ob[qd][dt]);
            }
        }
    }
#pragma unroll
    for (int qd = 0; qd < 4; ++qd) {
        const float lt = kg_allsum(l2[qd]);
        const float c2 = lt > 0.f ? g2w[qd] / lt : 0.f;
        bf16* op = A.o + (size_t)tqc[qd] * 1024 + head * 64 + 4 * kg;
#pragma unroll
        for (int dt = 0; dt < 4; ++dt) {
            const f32x4 o = park[(qd * 4 + dt) * 64] + Ob[qd][dt] * c2;
            u32x2 wv; wv.x = cvtpk(o[0], o[1]); wv.y = cvtpk(o[2], o[3]);
            *(u32x2*)(op + 16 * dt) = wv;
        }
    }
}

struct MobaT { const bf16* q; const bf16* k; const bf16* vT; const bf16* kmh; const bf16* kml; bf16* o; };
DI void ins3(u64 x, u64& k1, u64& k2, u64& k3) {
    const bool g1 = x > k1, g2 = x > k2, g3 = x > k3;
    const u64 n3 = g2 ? k2 : (g3 ? x : k3), n2 = g1 ? k1 : (g2 ? x : k2), n1 = g1 ? x : k1;
    k1 = n1; k2 = n2; k3 = n3;
}
DI void moba_unit(const MobaT& A, LAS unsigned char* lds, int h, int U, int w, int lane_in) {
    int lane = lane_id(); (void)lane_in;
    const int fr = lane & 15, kg = lane >> 4;
    const int t0 = U * 512 + w * 64;
    const int cur = t0 >> 8;
    bf16x8 qB[4][2]; int tqc[4];
#pragma unroll
    for (int nt = 0; nt < 4; ++nt) {
        tqc[nt] = t0 + 16 * nt + fr;
        const bf16* qp = A.q + (size_t)tqc[nt] * 1024 + h * 64 + 8 * kg;
        qB[nt][0] = ldg8(qp); qB[nt][1] = ldg8(qp + 32);
    }
    const f32x4 z4 = {0.f, 0.f, 0.f, 0.f};
    u64 selm[4] = {0ull, 0ull, 0ull, 0ull};
    if (cur > 0) {
        const int nmt = (cur + 15) >> 4;
        u64 k1[4], k2[4], k3[4];
#pragma unroll
        for (int nt = 0; nt < 4; ++nt) { k1[nt] = 0ull; k2[nt] = 0ull; k3[nt] = 0ull; }
        for (int mt = 0; mt < nmt; ++mt) {
            const size_t off = ((size_t)(h * 64 + 16 * mt + fr)) * 64 + 8 * kg;
            const bf16x8 ah0 = ldg8(A.kmh + off), ah1 = ldg8(A.kmh + off + 32), al0 = ldg8(A.kml + off), al1 = ldg8(A.kml + off + 32);
#pragma unroll
            for (int nt = 0; nt < 4; ++nt) {
                f32x4 s = MFMA16(ah0, qB[nt][0], z4); s = MFMA16(ah1, qB[nt][1], s); s = MFMA16(al0, qB[nt][0], s); s = MFMA16(al1, qB[nt][1], s);
#pragma unroll
                for (int i = 0; i < 4; ++i) {
                    const int b = 16 * mt + 4 * kg + i;
                    unsigned ub = __float_as_uint(s[i]); ub = (ub & 0x80000000u) ? ~ub : (ub | 0x80000000u);
                    const u64 x = (b < cur) ? (((u64)ub << 32) | (u64)(63 - b)) : 0ull;
                    ins3(x, k1[nt], k2[nt], k3[nt]);
                }
            }
        }
#pragma unroll
        for (int nt = 0; nt < 4; ++nt) {
#pragma unroll
            for (int o = 16; o < 64; o <<= 1) {
                const u64 p1 = ((u64)__shfl_xor((unsigned)(k1[nt] >> 32), o) << 32) | (u64)__shfl_xor((unsigned)k1[nt], o);
                const u64 p2 = ((u64)__shfl_xor((unsigned)(k2[nt] >> 32), o) << 32) | (u64)__shfl_xor((unsigned)k2[nt], o);
                const u64 p3 = ((u64)__shfl_xor((unsigned)(k3[nt] >> 32), o) << 32) | (u64)__shfl_xor((unsigned)k3[nt], o);
                ins3(p1, k1[nt], k2[nt], k3[nt]); ins3(p2, k1[nt], k2[nt], k3[nt]); ins3(p3, k1[nt], k2[nt], k3[nt]);
            }
            u64 sm = 0ull;
            if (k1[nt]) sm |= 1ull << (63 - (int)(k1[nt] & 63ull));
            if (k2[nt]) sm |= 1ull << (63 - (int)(k2[nt] & 63ull));
            if (k3[nt]) sm |= 1ull << (63 - (int)(k3[nt] & 63ull));
            selm[nt] = sm;
        }
    }
    f32x4 O[4][4]; float m[4], l[4];
#pragma unroll
    for (int a = 0; a < 4; ++a) { m[a] = -1e30f; l[a] = 0.f;
#pragma unroll
        for (int b = 0; b < 4; ++b) O[a][b] = z4; }
    const bf16* K = A.k + (size_t)h * S * 64;
    const bf16* VT = A.vT + (size_t)h * 64 * S;
    {
        const int nch = 2 * U + 2;
        const int roff = lds_roff(fr, kg);
        stage_chunk(lds, K, VT, S, 0, w, lane);
#pragma unroll 1
        for (int c = 0; c < nch; ++c) {
            VM_WAIT0(); __syncthreads();
            if (c + 1 < nch) stage_chunk(lds + ((c + 1) & 1) * 65536, K, VT, S, 256 * (c + 1), w, lane);
            const LAS unsigned char* cb = lds + (c & 1) * 65536;
            if (c < cur) {
                bool act[4]; bool any = false;
#pragma unroll
                for (int nt = 0; nt < 4; ++nt) { act[nt] = __ballot((selm[nt] >> c) & 1ull) != 0ull; any = any || act[nt]; }
                if (any) {
#pragma unroll 1
                    for (int st = 0; st < 8; ++st) {
                        bf16x8 kA[2][2]; lds_k(kA, cb + st * 8192, roff);
                        bf16x8 vA[4]; lds_v(vA, cb + st * 8192, roff);
#pragma unroll
                        for (int nt = 0; nt < 4; ++nt) {
                            if (!act[nt]) continue;
                            const bool colsel = (selm[nt] >> c) & 1ull;
                            f32x4 s0, s1; qk(s0, s1, kA, qB[nt], sm_init(m[nt], colsel));
                            const bf16x8 P = sm_step(s0, s1, m[nt], l[nt], O[nt]);
#pragma unroll
                            for (int dt = 0; dt < 4; ++dt) O[nt][dt] = MFMA16(vA[dt], P, O[nt][dt]);
                        }
                    }
                }
            } else if (c == cur) {
#pragma unroll 1
                for (int key0 = 256 * cur; key0 <= t0 + 32; key0 += 32) {
                    const int st = (key0 - 256 * cur) >> 5;
                    bf16x8 kA[2][2]; lds_k(kA, cb + st * 8192, roff);
                    bf16x8 vA[4]; lds_v(vA, cb + st * 8192, roff);
#pragma unroll
                    for (int nt = 0; nt < 4; ++nt) {
                        if (key0 > t0 + 16 * nt + 15) continue;
                        f32x4 s0, s1; qk(s0, s1, kA, qB[nt], sm_init(m[nt], true));
                        if (key0 + 31 > t0 + 16 * nt) {
#pragma unroll
                            for (int i = 0; i < 4; ++i) {
                                s0[i] = (key0 + 8 * kg + i <= tqc[nt]) ? s0[i] : -INFINITY;
                                s1[i] = (key0 + 8 * kg + 4 + i <= tqc[nt]) ? s1[i] : -INFINITY;
                            }
                        }
                        const bf16x8 P = sm_step(s0, s1, m[nt], l[nt], O[nt]);
#pragma unroll
                        for (int dt = 0; dt < 4; ++dt) O[nt][dt] = MFMA16(vA[dt], P, O[nt][dt]);
                    }
                }
            }
        }
        __syncthreads();
    }
#pragma unroll
    for (int nt = 0; nt < 4; ++nt) {
        const float lt = kg_allsum(l[nt]);
        const float c = lt > 0.f ? 1.0f / lt : 0.f;
        int l2_ = lane; asm volatile("" : "+v"(l2_));
        bf16* op = A.o + (size_t)(t0 + 16 * nt + (l2_ & 15)) * 1024 + h * 64 + 4 * (l2_ >> 4);
#pragma unroll
        for (int dt = 0; dt < 4; ++dt) {
            const f32x4 o = O[nt][dt] * c;
            u32x2 wv; wv.x = cvtpk(o[0], o[1]); wv.y = cvtpk(o[2], o[3]);
            *(u32x2*)(op + 16 * dt) = wv;
        }
    }
}

__global__ void __launch_bounds__(NTHR, 2) trunk_fwd(Args args) {
    extern __shared__ __attribute__((aligned(16))) unsigned char lds_raw[];
    LAS unsigned char* lds = (LAS unsigned char*)lds_raw;
    cg::grid_group grid = cg::this_grid();
    const int wave_s = __builtin_amdgcn_readfirstlane(threadIdx.x >> 6);
    if (threadIdx.x < 16) ((LAS unsigned*)(lds + 140000))[threadIdx.x] = 0u;
    __syncthreads();
    XcdBarrier xbar = xcd_barrier_post((unsigned*)args.ws + 4096, (volatile LAS unsigned*)(lds + 140000));
    xbar.w0 = (wave_s == 0);
    bool first_sync = true;
#define GRID_SYNC() do { if (first_sync) { grid.sync(); first_sync = false; } else xcd_barrier(xbar); } while (0)
    const int G = gridDim.x, bx = blockIdx.x, NGW = G * NWAVES;
#define FRESH_Z() ({ size_t z_ = 0; asm volatile("" : "+s"(z_)); z_; })
#define FRESH_WS() (args.ws + FRESH_Z())
#define FRESH_X() (args.out + FRESH_Z())
#define FRESH_IN(i) (args.in[i] + FRESH_Z())
#define PTRS() int tid = wave_s * 64 + lane_id(); asm volatile("" : "+v"(tid)); const int lane = tid & 63, wave = __builtin_amdgcn_readfirstlane(tid >> 6), gw = bx * NWAVES + wave; (void)lane; (void)gw; \
    unsigned char* ws = FRESH_WS(); float* X = FRESH_X(); \
    bf16* XB = (bf16*)(ws + WS_XB); float* TAB = (float*)(ws + WS_TAB); float* BIAS = (float*)(ws + WS_BIAS); \
    bf16* KMH = (bf16*)(ws + WS_KMEAN); bf16* KML = KMH + 16 * 64 * 64; \
    bf16* WA = (bf16*)(ws + WS_WA); bf16* WVT = (bf16*)(ws + WS_WVT); bf16* WO = (bf16*)(ws + WS_WO); \
    bf16* WC1 = (bf16*)(ws + WS_WC1); bf16* WC2 = (bf16*)(ws + WS_WC2); bf16* WGU = (bf16*)(ws + WS_WGU); bf16* WD = (bf16*)(ws + WS_WD); \
    bf16* Qb = (bf16*)(ws + WS_Q); bf16* Ob = (bf16*)(ws + WS_O); \
    bf16* KVC = (bf16*)(ws + WS_KVC); bf16* KSEL = (bf16*)(ws + WS_KSEL); bf16* KWIN = (bf16*)(ws + WS_KWIN); bf16* VSELT = (bf16*)(ws + WS_VSELT); \
    float* GATES = (float*)(ws + WS_GATES); bf16* HC = (bf16*)(ws + WS_HC); bf16* KC = (bf16*)(ws + WS_KC); bf16* VCT = (bf16*)(ws + WS_VCT); \
    bf16* MK = (bf16*)(ws + WS_MK); bf16* MVT = (bf16*)(ws + WS_MVT); bf16* HB = (bf16*)(ws + WS_H); \
    (void)X; (void)XB; (void)TAB; (void)BIAS; (void)KMH; (void)KML; (void)WA; (void)WVT; (void)WO; (void)WC1; (void)WC2; (void)WGU; (void)WD; (void)Qb; (void)Ob; \
    (void)KVC; (void)KSEL; (void)KWIN; (void)VSELT; (void)GATES; (void)HC; (void)KC; (void)VCT; (void)MK; (void)MVT; (void)HB;
    {
        PTRS();
        const f32x4* x4 = (const f32x4*)FRESH_IN(0); f32x4* o4 = (f32x4*)X; u32x2* b2 = (u32x2*)XB;
        for (size_t i = (size_t)bx * NTHR + tid; i < (size_t)S * D / 4; i += (size_t)G * NTHR) {
            const f32x4 v = x4[i]; o4[i] = v; u32x2 w; w.x = cvtpk(v[0], v[1]); w.y = cvtpk(v[2], v[3]); b2[i] = w; }
        for (int i = bx * NTHR + tid; i < S * 8; i += G * NTHR) {
            const int t = i >> 3, f = i & 7;
            const float invf = f == 0 ? 1.0f : f == 1 ? 0.19392274f : f == 2 ? 0.03760603f : f == 3 ? 0.0072926646f : f == 4 ? 0.0014142136f : f == 5 ? 0.0002742482f : f == 6 ? 5.3182957e-05f : 1.0313385e-05f;
            const float ang = (float)args.pos[t] * invf;
            const double a = (double)ang, k = __builtin_rint(a * 0.15915494309189535), r = a - k * 6.283185307179586476925;
            float sn, cs; sincos_d(r, sn, cs);
            TAB[t * 16 + f] = cs; TAB[t * 16 + 8 + f] = sn;
        }
    }

    for (int li = 0; li < 4; ++li) {
        const int lj = li >> 1; const bool nsa = (li & 1) == 0;
        {
            PTRS();
            ConvCtx c; c.scr = (LAS float*)(lds + wave * 16384); c.gw = gw; c.NGW = NGW; c.lane = lane; c.base = 0;
            if (nsa) {
                const float* win = FRESH_IN(2) + (size_t)lj * 1024 * 2608;
                conv_job(c, win, 2608, 1024, 1024, WA, 1024, 0);
                conv_job(c, win + 1024, 2608, 1024, 256, WA + (size_t)1024 * 1024, 1024, 0);
                conv_job(c, win + 1024 + 512, 2608, 1024, 256, WA + (size_t)1280 * 1024, 1024, 0);
                conv_job(c, win + 1024 + 1024, 2608, 1024, 256, WA + (size_t)1536 * 1024, 1024, 0);
                conv_job(c, win + 1024 + 256, 2608, 1024, 256, WA + (size_t)1792 * 1024, 1024, 0);
                conv_job(c, win + 2560, 2608, 1024, 48, WA + (size_t)2048 * 1024, 1024, 0);
                conv_job(c, win + 1024 + 768, 2608, 1024, 256, WVT, 1024, 0);
                conv_job(c, win + 1024 + 1280, 2608, 1024, 256, WVT + (size_t)256 * 1024, 1024, 0);
                conv_job(c, FRESH_IN(3) + (size_t)lj * 1024 * 1024, 1024, 1024, 1024, WO, 1024, 0);
                conv_job(c, FRESH_IN(5) + (size_t)lj * 2048 * 256, 256, 2048, 256, WC1, 2048, 0);
                conv_job(c, FRESH_IN(8) + (size_t)lj * 2048 * 256, 256, 2048, 256, WC1 + (size_t)256 * 2048, 2048, 0);
                conv_job(c, FRESH_IN(6) + (size_t)lj * 256 * 64, 64, 256, 64, WC2, 256, 0);
                conv_job(c, FRESH_IN(9) + (size_t)lj * 256 * 64, 64, 256, 64, WC2 + 64 * 256, 256, 0);
            } else {
                const float* win = FRESH_IN(10) + (size_t)lj * 1024 * 3072;
                conv_job(c, win, 3072, 1024, 2048, WA, 1024, 0);
                conv_job(c, win + 2048, 3072, 1024, 1024, WVT, 1024, 0);
                conv_job(c, FRESH_IN(11) + (size_t)lj * 1024 * 1024, 1024, 1024, 1024, WO, 1024, 0);
            }
            conv_job(c, FRESH_IN(12) + (size_t)li * 1024 * DFF, DFF, 1024, DFF, WGU, 1024, 1);
            conv_job(c, FRESH_IN(13) + (size_t)li * 1024 * DFF, DFF, 1024, DFF, WGU + (size_t)128 * 1024, 1024, 1);
            conv_job(c, FRESH_IN(14) + (size_t)li * DFF * 1024, 1024, DFF, 1024, WD, DFF, 0);
            if (nsa) {
                for (int it = gw; it < 128; it += NGW) {
                    const int kv = it >> 6, c4 = (it & 63) * 4;
                    const float* pe = FRESH_IN(kv ? 7 : 4) + (size_t)lj * 2048;
                    const float* w1 = FRESH_IN(kv ? 8 : 5) + (size_t)lj * 2048 * 256;
                    f32x4 s = {0.f, 0.f, 0.f, 0.f};
                    for (int r = lane; r < 2048; r += 64) { const f32x4 wv = *(const f32x4*)(w1 + (size_t)r * 256 + c4); s = s + wv * pe[r]; }
                    s[0] = wave_sum(s[0]); s[1] = wave_sum(s[1]); s[2] = wave_sum(s[2]); s[3] = wave_sum(s[3]);
                    if (lane == 0) *(f32x4*)(BIAS + kv * 256 + c4) = s;
                }
                if (bx == 0) { u32x4* z = (u32x4*)(KVC + (size_t)8 * S * 64); unsigned z0 = 0u; asm volatile("" : "+v"(z0)); if (tid < 256) z[tid] = (u32x4){z0, z0, z0, z0}; }
            }
        }
        GRID_SYNC();
        if (nsa) {
            {
                PTRS();
                pg8::Gemm g{XB, WA, S, 2304, 1024, 1024}; pg8::StaticOrder so; so.init(S, 2304, G, bx);
                EpiNsaA E{Qb, KVC, KSEL, KWIN, GATES, TAB};
                pg8::gemm_phase<EpiNsaA, pg8::StaticOrder, PG8_ALIGN, PG8_SP2>(lds, g, so, E, tid);
            }
            {
                PTRS();
                pg8::Gemm g{WVT, XB, 512, S, 1024, 1024}; pg8::StaticOrder so; so.init(512, S, G, bx);
                pg8::EpiBf16<0> E{VSELT, S, nullptr, 0, 0, 1.f};
                pg8::gemm_phase<pg8::EpiBf16<0>, pg8::StaticOrder, PG8_ALIGN, PG8_SP2>(lds, g, so, E, tid);
            }
            GRID_SYNC();
            {
                PTRS();
                pg8::Gemm g{KVC, WC1, 8192, 512, 2048, 1024}; CmpOrder so{G, bx};
                EpiCmp1 E{HC, BIAS};
                pg8::gemm_phase<EpiCmp1, CmpOrder, PG8_ALIGN, PG8_SP2>(lds, g, so, E, tid);
            }
            GRID_SYNC();
            { PTRS();
            for (int it = gw; it < 512; it += NGW) {
                const int fr = lane & 15, kg = lane >> 4;
                const int r0 = it * 16, kv = r0 >> 12, gg = (r0 >> 10) & 3, n = (r0 & 1023) + fr;
                const bf16* hp = HC + (size_t)(r0 + fr) * 256 + 8 * kg;
                const bf16* wp = WC2 + (size_t)(kv * 64 + fr) * 256 + 8 * kg;
                f32x4 C[4] = {{0.f, 0.f, 0.f, 0.f}, {0.f, 0.f, 0.f, 0.f}, {0.f, 0.f, 0.f, 0.f}, {0.f, 0.f, 0.f, 0.f}};
#pragma unroll
                for (int ks = 0; ks < 8; ++ks) {
                    const bf16x8 b = ldg8(hp + 32 * ks);
#pragma unroll
                    for (int dt = 0; dt < 4; ++dt) C[dt] = MFMA16(ldg8(wp + (size_t)(16 * dt) * 256 + 32 * ks), b, C[dt]);
                }
                if (kv == 0) {
#pragma unroll
                    for (int dt = 0; dt < 4; ++dt) { u32x2 wv; wv.x = cvtpk(C[dt][0], C[dt][1]); wv.y = cvtpk(C[dt][2], C[dt][3]);
                        *(u32x2*)(KC + ((size_t)gg * 1024 + n) * 64 + 16 * dt + 4 * kg) = wv; }
                } else {
#pragma unroll
                    for (int dt = 0; dt < 4; ++dt)
#pragma unroll
                        for (int i = 0; i < 4; ++i) VCT[((size_t)gg * 64 + 16 * dt + 4 * kg + i) * 1024 + n] = (bf16)(cvtpk(C[dt][i], 0.f) & 0xffffu);
                }
            }
            }
            GRID_SYNC();
            {
                PTRS();
                NsaT A{Qb, KSEL, KWIN, VSELT, VSELT + (size_t)256 * S, KC, VCT, GATES, Ob, (f32x4*)(ws + 192 * MiB)};
                for (int it = bx; it < 512; it += G) {
                    const int half = it >> 8, bb = it & 255, tb = bb >> 2, g = bb & 3;
                    const int T = half ? 127 - tb : tb;
                    nsa_unit(A, lds, T, g, wave, lane);
#ifdef DUP_NSA
                    nsa_unit(A, lds, T, g, wave, lane);
#endif
                }
            }
            GRID_SYNC();
        } else {
            {
                PTRS();
                pg8::Gemm g{XB, WA, S, 2048, 1024, 1024}; pg8::StaticOrder so; so.init(S, 2048, G, bx);
                EpiMobaA E{Qb, MK, TAB};
                pg8::gemm_phase<EpiMobaA, pg8::StaticOrder, PG8_ALIGN, PG8_SP2>(lds, g, so, E, tid);
            }
            {
                PTRS();
                pg8::Gemm g{WVT, XB, 1024, S, 1024, 1024}; pg8::StaticOrder so; so.init(1024, S, G, bx);
                pg8::EpiBf16<0> E{MVT, S, nullptr, 0, 0, 1.f};
                pg8::gemm_phase<pg8::EpiBf16<0>, pg8::StaticOrder, PG8_ALIGN, PG8_SP2>(lds, g, so, E, tid);
            }
            GRID_SYNC();
            { PTRS();
            for (int it = gw; it < 1024; it += NGW) {
                const int h = it >> 6, b = it & 63, rg = lane >> 3, c8 = lane & 7;
                const bf16* kp = MK + ((size_t)h * S + b * 256 + rg) * 64 + 8 * c8;
                float acc[8] = {0.f, 0.f, 0.f, 0.f, 0.f, 0.f, 0.f, 0.f};
#pragma unroll 4
                for (int r = 0; r < 32; ++r) { const bf16x8 v = ldg8(kp + (size_t)(8 * r) * 64);
#pragma unroll
                    for (int i = 0; i < 8; ++i) acc[i] += __uint_as_float(((unsigned)(unsigned short)v[i]) << 16); }
#pragma unroll
                for (int i = 0; i < 8; ++i) { acc[i] += __shfl_xor(acc[i], 8); acc[i] += __shfl_xor(acc[i], 16); acc[i] += __shfl_xor(acc[i], 32); acc[i] *= (1.0f / 256.0f); }
                if (lane < 8) {
                    float hi[8], lo[8];
#pragma unroll
                    for (int i = 0; i < 8; ++i) { const unsigned hb = cvtpk(acc[i], 0.f) & 0xffffu; hi[i] = __uint_as_float(hb << 16); lo[i] = acc[i] - hi[i]; }
                    *(u32x4*)(KMH + ((size_t)h * 64 + b) * 64 + 8 * c8) = pack8(hi);
                    *(u32x4*)(KML + ((size_t)h * 64 + b) * 64 + 8 * c8) = pack8(lo);
                }
            }
            }
            GRID_SYNC();
            {
                PTRS();
                MobaT A{Qb, MK, MVT, KMH, KML, Ob};
                for (int it = bx; it < 512; it += G) {
                    const int half = it >> 8, bb = it & 255, h = bb & 15, ub = bb >> 4;
                    const int U = half ? 31 - ub : ub;
                    moba_unit(A, lds, h, U, wave, lane);
#ifdef DUP_MOBA
                    moba_unit(A, lds, h, U, wave, lane);
#endif
                }
            }
            GRID_SYNC();
        }
        {
            PTRS();
            pg8::Gemm g{Ob, WO, S, 1024, 1024, 1024}; pg8::StaticOrder so; so.init(S, 1024, G, bx);
            EpiResid E{X};
            pg8::gemm_phase<EpiResid, pg8::StaticOrder, PG8_ALIGN, PG8_SP2>(lds, g, so, E, tid);
        }
        GRID_SYNC();
        { PTRS(); const float* gg_ = FRESH_IN(15) + li * D; const float* bb_ = FRESH_IN(16) + li * D;
          for (int r = gw; r < S; r += NGW) ln_row(X + (size_t)r * D, XB + (size_t)r * D, gg_, bb_, lane); }
        GRID_SYNC();
        {
            PTRS();
            pg8::Gemm g{XB, WGU, S, 2 * DFF, 1024, 1024}; pg8::StaticOrder so; so.init(S, 2 * DFF, G, bx);
            EpiSwiglu E{HB};
            pg8::gemm_phase<EpiSwiglu, pg8::StaticOrder, PG8_ALIGN, PG8_SP2>(lds, g, so, E, tid);
        }
        GRID_SYNC();
        {
            PTRS();
            pg8::Gemm g{HB, WD, S, 1024, DFF, DFF}; pg8::StaticOrder so; so.init(S, 1024, G, bx);
            EpiResid E{X};
            pg8::gemm_phase<EpiResid, pg8::StaticOrder, PG8_ALIGN, PG8_SP2>(lds, g, so, E, tid);
        }
        GRID_SYNC();
        { PTRS(); const float* gg_ = FRESH_IN(17) + li * D; const float* bb_ = FRESH_IN(18) + li * D;
          for (int r = gw; r < S; r += NGW) ln_row(X + (size_t)r * D, XB + (size_t)r * D, gg_, bb_, lane); }
        GRID_SYNC();
    }
}

extern "C" void kernel_launch(void* const* d_in, const int* in_sizes, int n_in, void* d_out, int out_size, void* d_ws, size_t ws_size, hipStream_t stream) {
    static int grid = 0;
    if (grid == 0) {
        int dev = 0, cus = 0, per_cu = 0;
        hipGetDevice(&dev);
        hipDeviceGetAttribute(&cus, hipDeviceAttributeMultiprocessorCount, dev);
        hipFuncSetAttribute((const void*)trunk_fwd, hipFuncAttributeMaxDynamicSharedMemorySize, LDS_BYTES);
        hipOccupancyMaxActiveBlocksPerMultiprocessor(&per_cu, (const void*)trunk_fwd, NTHR, LDS_BYTES);
        if (per_cu < 1) { fprintf(stderr, "kernel_launch: occupancy query says %d blocks per CU\n", per_cu); per_cu = 1; }
        if (per_cu > 1) per_cu = 1;
        grid = cus * per_cu;
        (void)hipGetLastError();
    }
    (void)hipMemsetAsync(d_ws, 0, 1u << 20, stream);
    Args a{};
    for (int i = 0; i < 19; ++i) a.in[i] = (const float*)d_in[i];
    a.pos = (const int*)d_in[1]; a.out = (float*)d_out; a.ws = (unsigned char*)d_ws;
    void* kargs[] = {&a};
    hipError_t e = hipLaunchCooperativeKernel((const void*)trunk_fwd, dim3(grid), dim3(NTHR), kargs, LDS_BYTES, stream);
    if (e != hipSuccess) fprintf(stderr, "cooperative launch failed: %s (grid %d)\n", hipGetErrorString(e), grid);
}
```

```cpp
#include <hip/hip_runtime.h>
#include <hip/hip_cooperative_groups.h>
#include <cstdio>
#include <cstdint>
namespace cg = cooperative_groups;
namespace pg8 {
#define PG8_LAS __attribute__((address_space(3)))
typedef unsigned short bf16_t;
typedef short bf16x8 __attribute__((ext_vector_type(8)));
typedef float f32x4 __attribute__((ext_vector_type(4)));
typedef unsigned u32x4 __attribute__((ext_vector_type(4)));
constexpr int BM = 256, BK = 64, HALF = 128, HTB = HALF * BK * 2  , STAGE_BYTES = 8 * HTB, NXCD = 8, WGM = 8;

__host__ __device__ __forceinline__ int lds_byte(int r, int c) { const int st = (r >> 4) * 2 + (c >> 5), rr = r & 15, cc = c & 31, ob = rr * 64 + cc * 2; return st * 1024 + (ob ^ (((ob >> 9) & 1) << 5)); }
__host__ __device__ __forceinline__ void stage_rc(int b, int& R, int& C) { const int st = b / 1024, sb = b % 1024, swz = sb ^ (((sb >> 9) & 1) << 5); R = (st >> 1) * 16 + swz / 64; C = (st & 1) * 32 + (swz % 64) / 2; }
__host__ __device__ __forceinline__ int perm32(int rho) { const int n = rho >> 4, i = rho & 15; return 8 * (i >> 2) + 4 * n + (i & 3); }

struct Unit { int pm, pn; };
struct Gemm { const bf16_t* A; const bf16_t* Bt; int M, N, K, lda; };

struct StaticOrder {
    int nM, nN, nwg, G, c;
    __host__ __device__ void init(int M, int N, int G_, int c_) { nM = M / BM; nN = N / BM; nwg = nM * nN; G = G_; c = c_; }
    __host__ __device__ bool next(int i, Unit& u) const {
        const long L = (long)i * G + c; if (L >= nwg) return false;
        int wgid = (int)L; { const int q = nwg / NXCD, r = nwg % NXCD, xcd = wgid % NXCD, off = wgid / NXCD; wgid = (xcd < r ? xcd * (q + 1) : r * (q + 1) + (xcd - r) * q) + off; }
        const int nig = WGM * nN, gid = wgid / nig, fm = gid * WGM, gsz = (nM - fm) < WGM ? (nM - fm) : WGM;
        u.pm = fm + ((wgid % nig) % gsz); u.pn = (wgid % nig) / gsz; return true;
    }
    __device__ __forceinline__ void a_ready(const Unit&) const {}
    __device__ __forceinline__ void done(const Unit&) const {}
};

__device__ __forceinline__ unsigned cvt_pk_bf16(float lo, float hi) { unsigned r; asm volatile("v_cvt_pk_bf16_f32 %0, %1, %2" : "=v"(r) : "v"(lo), "v"(hi)); return r; }
typedef float f32x2 __attribute__((ext_vector_type(2)));
__device__ __forceinline__ f32x2 gelu_pk(f32x2 v) {
    const f32x2 av = __builtin_elementwise_abs(v), d = av * 0.2316418882f + 1.0f;
    f32x2 t; t.x = __builtin_amdgcn_rcpf(d.x); t.y = __builtin_amdgcn_rcpf(d.y);
    f32x2 q = t * 0.5307027145f + (-0.7265760135f); q = q * t + 0.7107068705f; q = q * t + (-0.142248368f); q = q * t + 0.127414796f; q = q * t;
    const f32x2 s = (v * v) * (-0.72134752044f);
    f32x2 e; e.x = __builtin_amdgcn_exp2f(s.x); e.y = __builtin_amdgcn_exp2f(s.y);
    const f32x2 m = v * (q * e), r = v - m;
    f32x2 o; o.x = v.x < 0.f ? m.x : r.x; o.y = v.y < 0.f ? m.y : r.y; return o;
}

template <int ACT  > struct EpiBf16 {
    static constexpr bool PERM = true, AFTER_DRAIN = false; static_assert(ACT == 0 || ACT == 1, "EpiBf16: ACT is 0 (none) or 1 (gelu_pk)");
    bf16_t* O; int ldc; const float* bias; int split_cols; size_t split_stride; float scale0;
    __device__ __forceinline__ void operator()(const f32x4 (&acc)[2][2][4][2], const Unit& u, int wr, int wc, int fr, int fq) const {
        const int row0 = u.pm * BM + wr * 64 + fr; int colt = u.pn * BM; bf16_t* base = O;
        float sc = 1.f; if (split_cols) { const int t = colt / split_cols; base += (size_t)t * split_stride; colt -= t * split_cols; if (t == 0) sc = scale0; }
        const int col0 = colt + wc * 32 + 8 * fq, bcol0 = u.pn * BM + wc * 32 + 8 * fq;
        f32x4 bv[2][2];
#pragma unroll
        for (int bj = 0; bj < 2; ++bj)
#pragma unroll
            for (int n = 0; n < 2; ++n) bv[bj][n] = bias ? *(const f32x4*)(bias + bcol0 + bj * HALF + 4 * n) : (f32x4){0.f, 0.f, 0.f, 0.f};
#pragma unroll
        for (int ai = 0; ai < 2; ++ai)
#pragma unroll
            for (int m = 0; m < 4; ++m) { bf16_t* rowp = base + (size_t)(row0 + ai * HALF + m * 16) * ldc + col0;
#pragma unroll
                for (int bj = 0; bj < 2; ++bj) { f32x4 v0 = acc[ai][bj][m][0] + bv[bj][0], v1 = acc[ai][bj][m][1] + bv[bj][1];
                    if (ACT == 1) { f32x2 a = gelu_pk((f32x2){v0[0], v0[1]}), b = gelu_pk((f32x2){v0[2], v0[3]}), c = gelu_pk((f32x2){v1[0], v1[1]}), d = gelu_pk((f32x2){v1[2], v1[3]});
                        v0 = (f32x4){a.x, a.y, b.x, b.y}; v1 = (f32x4){c.x, c.y, d.x, d.y}; }
                    v0 = v0 * sc; v1 = v1 * sc; u32x4 w; w.x = cvt_pk_bf16(v0[0], v0[1]); w.y = cvt_pk_bf16(v0[2], v0[3]); w.z = cvt_pk_bf16(v1[0], v1[1]); w.w = cvt_pk_bf16(v1[2], v1[3]);
                    *(u32x4*)(rowp + bj * HALF) = w; } }
    }
};
template <class Epi, class Sched, bool ALIGN_EPI = false, bool SP2 = false>
__device__ __forceinline__ void gemm_phase(PG8_LAS unsigned char* lds, const Gemm g, const Sched& S, const Epi& E, int tid_in) {
    int tid_l = tid_in; asm volatile("" : "+v"(tid_l)); const int tid = tid_l, wid = __builtin_amdgcn_readfirstlane(tid >> 6), lane = tid & 63, wr = wid >> 2, wc = wid & 3, fr = lane & 15, fq = lane >> 4;
    const int K = g.K, nt = K / BK;
    unsigned voffA[2], voffB[2];
#pragma unroll
    for (int i = 0; i < 2; ++i) { int R, C; stage_rc(tid * 16 + i * 8192, R, C); const int Rb = Epi::PERM ? ((R & ~31) + perm32(R & 31)) : R;
        voffA[i] = (unsigned)(R * g.lda + C) * 2u; voffB[i] = (unsigned)(Rb * K + C) * 2u; }
    const size_t kstep = (size_t)(BK * 2);
    const size_t hstepB = (size_t)HALF * K * 2, hstepA = (size_t)HALF * g.lda * 2;
    const size_t tstepB = 2 * hstepB, tstepA = 2 * hstepA;
    const unsigned ldsw = (unsigned)wid * 1024u;
    const int aoff = lds_byte(wr * 64 + fr, fq * 8), boff = lds_byte(wc * 32 + fr, fq * 8);
#define PG8_SA(b, h) (((b) * 2 + (h)) * HTB)
#define PG8_SB(b, h) ((4 + (b) * 2 + (h)) * HTB)
#define PG8_STAGE(bufoff, gbase, voff) do { _Pragma("unroll") for (int _i = 0; _i < 2; ++_i) \
        __builtin_amdgcn_global_load_lds((const unsigned*)((const char*)(gbase) + (voff)[_i]), (PG8_LAS unsigned*)(lds + (bufoff) + ldsw + _i * 8192), 16, 0, 0); } while (0)
#define PG8_LDA(dst, b, h) do { _Pragma("unroll") for (int m = 0; m < 4; ++m) _Pragma("unroll") for (int k = 0; k < 2; ++k) dst[m][k] = *(const PG8_LAS bf16x8*)(lds + PG8_SA(b, h) + aoff + m * 2048 + k * 1024); } while (0)
#define PG8_LDB(dst, b, h) do { _Pragma("unroll") for (int n = 0; n < 2; ++n) _Pragma("unroll") for (int k = 0; k < 2; ++k) dst[n][k] = *(const PG8_LAS bf16x8*)(lds + PG8_SB(b, h) + boff + n * 2048 + k * 1024); } while (0)
#define PG8_MMA(ai, bj, At, Bt) do { __builtin_amdgcn_s_setprio(1); _Pragma("unroll") for (int m = 0; m < 4; ++m) _Pragma("unroll") for (int n = 0; n < 2; ++n) _Pragma("unroll") for (int k = 0; k < 2; ++k) \
        acc[ai][bj][m][n] = __builtin_amdgcn_mfma_f32_16x16x32_bf16(Bt[n][k], At[m][k], acc[ai][bj][m][n], 0, 0, 0); __builtin_amdgcn_s_setprio(0); } while (0)
#define PG8_WAIT_V(n) asm volatile("s_waitcnt vmcnt(" #n ")" ::: "memory")
#define PG8_WAIT_L(n) asm volatile("s_waitcnt lgkmcnt(" #n ")" ::: "memory")
#define PG8_BAR __builtin_amdgcn_s_barrier()
#define PG8_SCHED __builtin_amdgcn_sched_barrier(0)
    Unit cur, nxt; int ui = 0;
    if (!S.next(0, cur)) return;
    f32x4 acc[2][2][4][2];
#pragma unroll
    for (int a = 0; a < 2; ++a)
#pragma unroll
        for (int b = 0; b < 2; ++b)
#pragma unroll
            for (int m = 0; m < 4; ++m)
#pragma unroll
                for (int n = 0; n < 2; ++n) acc[a][b][m][n] = (f32x4){0.f, 0.f, 0.f, 0.f};
    bf16x8 At[4][2], B0[2][2], B1[2][2];
    const char* cA = (const char*)g.A + (size_t)cur.pm * tstepA; const char* cB = (const char*)g.Bt + (size_t)cur.pn * tstepB;
    S.a_ready(cur);
    if constexpr (SP2) {
        PG8_STAGE(PG8_SB(0, 0), cB, voffB); PG8_STAGE(PG8_SB(0, 1), cB + hstepB, voffB); PG8_STAGE(PG8_SA(0, 0), cA, voffA); PG8_STAGE(PG8_SA(0, 1), cA + hstepA, voffA);
        if (wr == 1) PG8_BAR;
        PG8_WAIT_V(2); PG8_BAR;
        PG8_STAGE(PG8_SB(1, 0), cB + kstep, voffB); PG8_STAGE(PG8_SA(1, 0), cA + kstep, voffA); PG8_STAGE(PG8_SB(1, 1), cB + hstepB + kstep, voffB);
        PG8_WAIT_V(6); PG8_BAR;
    } else {
        PG8_STAGE(PG8_SB(0, 0), cB, voffB); PG8_STAGE(PG8_SA(0, 0), cA, voffA); PG8_STAGE(PG8_SB(0, 1), cB + hstepB, voffB); PG8_STAGE(PG8_SA(0, 1), cA + hstepA, voffA);
        if (wr == 1) PG8_BAR;
        PG8_WAIT_V(4); PG8_BAR;
        PG8_STAGE(PG8_SB(1, 0), cB + kstep, voffB); PG8_STAGE(PG8_SA(1, 0), cA + kstep, voffA); PG8_STAGE(PG8_SB(1, 1), cB + hstepB + kstep, voffB);
        PG8_WAIT_V(6); PG8_BAR;
    }
    for (;;) {
        const bool has_next = S.next(ui + 1, nxt);
        const char* nA = has_next ? (const char*)g.A + (size_t)nxt.pm * tstepA : cA; const char* nB = has_next ? (const char*)g.Bt + (size_t)nxt.pn * tstepB : cB;
        for (int t = 0; t < nt; t += 2) {
            const bool last = (t == nt - 2);
            const char* a1 = cA + (size_t)(t + 1) * kstep;
            const char* a2 = last ? nA : cA + (size_t)(t + 2) * kstep; const char* b2 = last ? nB : cB + (size_t)(t + 2) * kstep;
            const char* a3 = a2 + kstep; const char* b3 = b2 + kstep;
            if (last && has_next) S.a_ready(nxt);
            if constexpr (SP2) {
            PG8_LDB(B0, 0, 0); PG8_LDB(B1, 0, 1); PG8_SCHED; PG8_LDA(At, 0, 0); PG8_STAGE(PG8_SA(1, 1), a1 + hstepA, voffA);
            PG8_WAIT_V(8); PG8_WAIT_L(0); PG8_BAR; PG8_MMA(0, 0, At, B0); PG8_MMA(0, 1, At, B1); PG8_BAR; PG8_SCHED;
            PG8_LDA(At, 0, 1); PG8_STAGE(PG8_SB(0, 0), b2, voffB); PG8_STAGE(PG8_SB(0, 1), b2 + hstepB, voffB); PG8_STAGE(PG8_SA(0, 0), a2, voffA);
            PG8_WAIT_V(8); PG8_WAIT_L(0); PG8_BAR; PG8_MMA(1, 0, At, B0); PG8_MMA(1, 1, At, B1); PG8_BAR; PG8_SCHED;
            PG8_LDB(B0, 1, 0); PG8_LDB(B1, 1, 1); PG8_SCHED; PG8_LDA(At, 1, 0); PG8_STAGE(PG8_SA(0, 1), a2 + hstepA, voffA);
            PG8_WAIT_V(8); PG8_WAIT_L(0); PG8_BAR; PG8_MMA(0, 0, At, B0); PG8_MMA(0, 1, At, B1); PG8_BAR; PG8_SCHED;
            PG8_LDA(At, 1, 1); PG8_STAGE(PG8_SB(1, 0), b3, voffB); PG8_STAGE(PG8_SB(1, 1), b3 + hstepB, voffB); PG8_STAGE(PG8_SA(1, 0), a3, voffA);
            PG8_WAIT_V(8); PG8_WAIT_L(0); PG8_BAR; PG8_MMA(1, 0, At, B0); PG8_MMA(1, 1, At, B1); PG8_BAR; PG8_SCHED;
            } else {
            PG8_LDB(B0, 0, 0); PG8_SCHED; PG8_LDA(At, 0, 0); PG8_STAGE(PG8_SA(1, 1), a1 + hstepA, voffA);
            PG8_WAIT_L(8); PG8_BAR; PG8_WAIT_L(0); PG8_MMA(0, 0, At, B0); PG8_BAR; PG8_SCHED;
            PG8_LDB(B1, 0, 1); PG8_STAGE(PG8_SB(0, 0), b2, voffB);
            PG8_BAR; PG8_WAIT_L(0); PG8_MMA(0, 1, At, B1); PG8_BAR;
            PG8_LDA(At, 0, 1); PG8_STAGE(PG8_SA(0, 0), a2, voffA);
            PG8_BAR; PG8_WAIT_L(0); PG8_MMA(1, 0, At, B0); PG8_BAR; PG8_SCHED;
            PG8_STAGE(PG8_SB(0, 1), b2 + hstepB, voffB);
            PG8_WAIT_V(6); PG8_BAR; PG8_MMA(1, 1, At, B1); PG8_BAR;
            PG8_LDB(B0, 1, 0); PG8_SCHED; PG8_LDA(At, 1, 0); PG8_STAGE(PG8_SA(0, 1), a2 + hstepA, voffA);
            PG8_WAIT_L(8); PG8_BAR; PG8_WAIT_L(0); PG8_MMA(0, 0, At, B0); PG8_BAR; PG8_SCHED;
            PG8_LDB(B1, 1, 1); PG8_STAGE(PG8_SB(1, 0), b3, voffB);
            PG8_BAR; PG8_WAIT_L(0); PG8_MMA(0, 1, At, B1); PG8_BAR;
            PG8_LDA(At, 1, 1); PG8_STAGE(PG8_SA(1, 0), a3, voffA);
            PG8_BAR; PG8_WAIT_L(0); PG8_MMA(1, 0, At, B0); PG8_BAR; PG8_SCHED;
            PG8_STAGE(PG8_SB(1, 1), b3 + hstepB, voffB);
            PG8_WAIT_V(6); PG8_BAR; PG8_MMA(1, 1, At, B1); PG8_BAR;
            }
        }
        if constexpr (ALIGN_EPI) { if (wr == 0) PG8_BAR; }
        if constexpr (!Epi::AFTER_DRAIN) { E(acc, cur, wr, wc, fr, fq); S.done(cur); }
        if (!has_next) break;
#pragma unroll
        for (int a = 0; a < 2; ++a)
#pragma unroll
            for (int b = 0; b < 2; ++b)
#pragma unroll
                for (int m = 0; m < 4; ++m)
#pragma unroll
                    for (int n = 0; n < 2; ++n) acc[a][b][m][n] = (f32x4){0.f, 0.f, 0.f, 0.f};
        cur = nxt; cA = nA; cB = nB; ++ui;
        if constexpr (ALIGN_EPI) { if (wr == 1) PG8_BAR; }
    }
    PG8_WAIT_V(0);
    if constexpr (!ALIGN_EPI) { if (wr == 0) PG8_BAR; }
    PG8_BAR;
    if constexpr (Epi::AFTER_DRAIN) { E.fused(acc, cur, wr, wc, fr, fq, lds, wid, lane); S.done(cur); }
#undef PG8_SA
#undef PG8_SB
#undef PG8_STAGE
#undef PG8_LDA
#undef PG8_LDB
#undef PG8_MMA
#undef PG8_WAIT_V
#undef PG8_WAIT_L
#undef PG8_BAR
#undef PG8_SCHED
}
}
#ifndef PG8_SP2
#define PG8_SP2 true
#endif
#ifndef PG8_ALIGN
#define PG8_ALIGN true
#endif
#define LAS __attribute__((address_space(3)))
#define DI __device__ __forceinline__
typedef unsigned short bf16;
typedef short bf16x8 __attribute__((ext_vector_type(8)));
typedef float f32x4 __attribute__((ext_vector_type(4)));
typedef unsigned u32x4 __attribute__((ext_vector_type(4)));
typedef unsigned u32x2 __attribute__((ext_vector_type(2)));
typedef float f32x2_t __attribute__((ext_vector_type(2)));
typedef __bf16 bf16x2_t __attribute__((ext_vector_type(2)));
typedef unsigned long long u64;

constexpr int S = 16384, D = 1024, DFF = 2816, NH = 16, HD = 64;
constexpr int NWAVES = 8, NTHR = 512;
constexpr float ALPHA_F = 1.681792830507429f;
constexpr float QSCALE = 0.125f * 1.4426950408889634f;
constexpr float LN_EPS = 1e-5f;
constexpr int LDS_BYTES = 147456;

constexpr size_t MiB = 1u << 20;
constexpr size_t WS_TAB = 1 * MiB;
constexpr size_t WS_BIAS = 2 * MiB;
constexpr size_t WS_KMEAN = 2 * MiB + 65536;
constexpr size_t WS_WA = 4 * MiB;
constexpr size_t WS_WVT = WS_WA + 4608 * 1024;
constexpr size_t WS_WO = WS_WVT + 2 * MiB;
constexpr size_t WS_WC1 = WS_WO + 2 * MiB;
constexpr size_t WS_WC2 = WS_WC1 + 2 * MiB;
constexpr size_t WS_WGU = WS_WC2 + 65536;
constexpr size_t WS_WD = WS_WGU + 11 * MiB;
static_assert(WS_WD + 5767168 <= 32 * MiB, "weights region");
constexpr size_t WS_XB = 32 * MiB;
constexpr size_t WS_ACT = 64 * MiB;
constexpr size_t WS_Q = WS_ACT;
constexpr size_t WS_O = WS_ACT + 32 * MiB;
constexpr size_t WS_KVC = WS_ACT + 64 * MiB;
constexpr size_t WS_KSEL = WS_KVC + 17 * MiB;
constexpr size_t WS_KWIN = WS_KSEL + 8 * MiB;
constexpr size_t WS_VSELT = WS_KWIN + 8 * MiB;
constexpr size_t WS_GATES = WS_VSELT + 16 * MiB;
constexpr size_t WS_HC = WS_GATES + 3 * MiB;
constexpr size_t WS_KC = WS_HC + 4 * MiB;
constexpr size_t WS_VCT = WS_KC + 512 * 1024;
constexpr size_t WS_MK = WS_ACT + 64 * MiB;
constexpr size_t WS_MVT = WS_MK + 32 * MiB;
constexpr size_t WS_H = WS_ACT;
constexpr size_t WS_END = 256 * MiB;
static_assert(WS_VCT + 512 * 1024 <= WS_END && WS_MVT + 32 * MiB <= WS_END && WS_H + (size_t)S * DFF * 2 <= WS_END, "ws map");

DI unsigned cvtpk(float lo, float hi) { f32x2_t v = {lo, hi}; bf16x2_t b = __builtin_convertvector(v, bf16x2_t); return __builtin_bit_cast(unsigned, b); }
DI int lane_id() { int l; asm volatile("v_mbcnt_lo_u32_b32 %0, -1, 0\n\tv_mbcnt_hi_u32_b32 %0, -1, %0" : "=v"(l)); return l; }
DI float mx2(float a, float b) { return __builtin_amdgcn_fmed3f(a, b, __builtin_inff()); }
DI float ex2(float x) { return __builtin_amdgcn_exp2f(x); }
DI bf16x8 ldg8(const bf16* p) { return *(const bf16x8*)p; }
#define MFMA16(a, b, c) __builtin_amdgcn_mfma_f32_16x16x32_bf16((a), (b), (c), 0, 0, 0)
#define LDS_WAIT() asm volatile("s_waitcnt lgkmcnt(0)" ::: "memory")

DI unsigned x16u(unsigned x, int kg) { auto r = __builtin_amdgcn_permlane16_swap(x, x, false, false); return (kg & 1) ? r[0] : r[1]; }
DI unsigned x32u(unsigned x, int kg) { auto r = __builtin_amdgcn_permlane32_swap(x, x, false, false); return (kg & 2) ? r[0] : r[1]; }
DI u64 x16q(u64 x, int kg) { return ((u64)x16u((unsigned)(x >> 32), kg) << 32) | (u64)x16u((unsigned)x, kg); }
DI u64 x32q(u64 x, int kg) { return ((u64)x32u((unsigned)(x >> 32), kg) << 32) | (u64)x32u((unsigned)x, kg); }
template <int CTRL> DI float dppf(float v) { return __int_as_float(__builtin_amdgcn_update_dpp(0, __float_as_int(v), CTRL, 0xf, 0xf, true)); }
template <int CTRL> DI unsigned dppu(unsigned v) { return (unsigned)__builtin_amdgcn_update_dpp(0, (int)v, CTRL, 0xf, 0xf, true); }
DI float kg_allsum(float x) {
    auto r = __builtin_amdgcn_permlane16_swap(__float_as_uint(x), __float_as_uint(x), false, false);
    x = __uint_as_float(r[0]) + __uint_as_float(r[1]);
    auto q = __builtin_amdgcn_permlane32_swap(__float_as_uint(x), __float_as_uint(x), false, false);
    return __uint_as_float(q[0]) + __uint_as_float(q[1]);
}
DI float wave_sum(float v) {
    v += dppf<0xB1>(v); v += dppf<0x4E>(v); v += dppf<0x141>(v); v += dppf<0x140>(v);
    return kg_allsum(v);
}

#define XB_TMO      128
#define XB_XCNT(j)  (256  + 64 * (j))
#define XB_XSUB(j)  (1280 + 64 * (j))
#define XB_XGEN(j)  (2304 + 64 * (j))
#define XB_TOP      3328
#define XB_TOPGEN   3392
#define XCD_BAR_WORDS 3456
#define XB_SPIN_CAP (1u << 18)

__device__ __forceinline__ unsigned xb_ld(unsigned* p)              { return __hip_atomic_load(p, __ATOMIC_RELAXED, __HIP_MEMORY_SCOPE_AGENT); }
__device__ __forceinline__ unsigned xb_add(unsigned* p, unsigned v) { return __hip_atomic_fetch_add(p, v, __ATOMIC_RELAXED, __HIP_MEMORY_SCOPE_AGENT); }
__device__ __forceinline__ unsigned xb_xcc_id() { return (unsigned)__builtin_amdgcn_s_getreg((3 << 11) | 20) & 0xFu; }
#define XB_SPIN(cond, bar) do { unsigned _sp = 0; while (cond) { __builtin_amdgcn_s_sleep(1); \
    if ((++_sp & 255u) == 0u) { if (xb_ld(&(bar)[XB_TMO])) break; if (_sp > XB_SPIN_CAP) { atomicAdd(&(bar)[XB_TMO], 1u); break; } } } } while (0)

struct XcdBarrier {
    bool w0; unsigned* bar; unsigned x;
    volatile LAS unsigned* st;
};

__device__ __forceinline__ XcdBarrier xcd_barrier_post(unsigned* bar, volatile LAS unsigned* st) {
    XcdBarrier b; b.bar = bar; b.x = xb_xcc_id(); b.st = st;
    if (threadIdx.x == 0) (void)xb_add(&bar[XB_XCNT(b.x)], 1u);
    return b;
}
__device__ __forceinline__ void xcd_barrier_complete(unsigned* bar, unsigned x, unsigned& nloc, unsigned& nx) {
    const unsigned G = gridDim.x * gridDim.y * gridDim.z;
    unsigned sum, cnt, mine, sp = 0u;
    for (;;) {
        sum = 0u; cnt = 0u; mine = 0u;
#pragma unroll
        for (unsigned j = 0; j < 16; ++j) { const unsigned c = xb_ld(&bar[XB_XCNT(j)]); sum += c; cnt += (c > 0u) ? 1u : 0u; mine = (j == x) ? c : mine; }
        if (sum == G) break;
        __builtin_amdgcn_s_sleep(1);
        if ((++sp & 255u) == 0u) { if (xb_ld(&bar[XB_TMO])) break; if (sp > XB_SPIN_CAP) { atomicAdd(&bar[XB_TMO], 1u); break; } }
    }
    nloc = mine > 0u ? mine : 1u; nx = cnt > 0u ? cnt : 1u;
}

__device__ __forceinline__ void xcd_barrier(const XcdBarrier& b) {
    asm volatile("s_waitcnt vmcnt(0)" ::: "memory");
    __syncthreads();
    if (b.w0 && lane_id() == 0) {
        unsigned* bar = b.bar;
        __builtin_amdgcn_s_waitcnt(0);
        unsigned nloc = b.st[0], nx = b.st[1];
        if (nloc == 0u) { xcd_barrier_complete(bar, b.x, nloc, nx); b.st[0] = nloc; b.st[1] = nx; }
        const unsigned old = xb_add(&bar[XB_XSUB(b.x)], 1u);
        const unsigned gen = old / nloc;
        if (old + 1u == (gen + 1u) * nloc) {
            __builtin_amdgcn_fence(__ATOMIC_RELEASE, "agent");
            asm volatile("s_waitcnt vmcnt(0)" ::: "memory");
            const unsigned og = xb_add(&bar[XB_TOP], 1u);
            const unsigned tg = og / nx;
            if (og + 1u == (tg + 1u) * nx) xb_add(&bar[XB_TOPGEN], 1u);
            else XB_SPIN(xb_ld(&bar[XB_TOPGEN]) == tg, bar);
            __builtin_amdgcn_fence(__ATOMIC_ACQUIRE, "agent");
            xb_add(&bar[XB_XGEN(b.x)], 1u);
            asm volatile("s_waitcnt vmcnt(0)" ::: "memory");
        } else {
            XB_SPIN(xb_ld(&bar[XB_XGEN(b.x)]) == gen, bar);
            __builtin_amdgcn_fence(__ATOMIC_ACQUIRE, "agent");
            asm volatile("s_waitcnt vmcnt(0)" ::: "memory");
        }
    }
    __syncthreads();
}


struct Args { const float* in[19]; const int* pos; float* out; unsigned char* ws; };

struct CmpOrder {
    int G, c;
    __device__ bool next(int i, pg8::Unit& u) const { const int L = i * G + c; if (L >= 32) return false; u.pm = L; u.pn = L >> 4; return true; }
    DI void a_ready(const pg8::Unit&) const {}
    DI void done(const pg8::Unit&) const {}
};

DI void rope8(float (&v)[8], const float* tabrow, int fq) {
    float p[8];
#pragma unroll
    for (int i = 0; i < 8; ++i) p[i] = __uint_as_float(x16u(__float_as_uint(v[i]), fq));
    if (fq < 2) {
        const f32x4 c0 = *(const f32x4*)(tabrow), c1 = *(const f32x4*)(tabrow + 4), s0 = *(const f32x4*)(tabrow + 8), s1 = *(const f32x4*)(tabrow + 12);
        const float cs[8] = {c0[0], c0[1], c0[2], c0[3], c1[0], c1[1], c1[2], c1[3]};
        const float sn[8] = {s0[0], s0[1], s0[2], s0[3], s1[0], s1[1], s1[2], s1[3]};
#pragma unroll
        for (int i = 0; i < 8; ++i) v[i] = (fq == 0) ? (v[i] * cs[i] - p[i] * sn[i]) : (v[i] * cs[i] + p[i] * sn[i]);
    }
}
DI u32x4 pack8(const float (&v)[8]) { u32x4 w; w.x = cvtpk(v[0], v[1]); w.y = cvtpk(v[2], v[3]); w.z = cvtpk(v[4], v[5]); w.w = cvtpk(v[6], v[7]); return w; }

struct EpiNsaA {
    static constexpr bool PERM = true, AFTER_DRAIN = false;
    bf16* q; bf16* kvc; bf16* ksel; bf16* kwin; float* gates; const float* tab;
    DI void operator()(const f32x4 (&acc)[2][2][4][2], const pg8::Unit& u, int wr, int wc, int fr, int fq) const {
        const int pn = u.pn;
        const bool rope = (pn != 7) && (pn != 8) && ((wc & 1) == 0);
#pragma unroll
        for (int ai = 0; ai < 2; ++ai)
#pragma unroll
            for (int m = 0; m < 4; ++m) {
                const int row = u.pm * 256 + ai * 128 + wr * 64 + m * 16 + fr;
#pragma unroll
                for (int bj = 0; bj < 2; ++bj) {
                    const int cb = bj * 128 + wc * 32 + 8 * fq;
                    float v[8];
#pragma unroll
                    for (int i = 0; i < 4; ++i) { v[i] = acc[ai][bj][m][0][i]; v[4 + i] = acc[ai][bj][m][1][i]; }
                    if (pn == 8) {
                        if (cb < 48) {
#pragma unroll
                            for (int i = 0; i < 8; ++i) v[i] = 1.0f / (1.0f + __expf(-v[i]));
                            float* gp = gates + (size_t)row * 48 + cb;
                            *(f32x4*)gp = (f32x4){v[0], v[1], v[2], v[3]}; *(f32x4*)(gp + 4) = (f32x4){v[4], v[5], v[6], v[7]};
                        }
                        continue;
                    }
                    if (rope) rope8(v, tab + (size_t)row * 16, fq);
                    if (pn < 4) {
#pragma unroll
                        for (int i = 0; i < 8; ++i) v[i] *= QSCALE;
                        *(u32x4*)(q + (size_t)row * 1024 + pn * 256 + cb) = pack8(v);
                    } else {
                        const int g = cb >> 6, d = cb & 63;
                        if (pn == 5 || pn == 6) {
                            bf16* base = (pn == 5) ? ksel : kwin; const int kap = row & 31;
                            const int lanef = ((d & 31) >> 3) * 16 + 4 * (kap >> 3) + (kap & 3);
                            *(u32x4*)(base + (size_t)g * S * 64 + ((size_t)(((row >> 5) * 2 + ((kap >> 2) & 1)) * 2 + (d >> 5))) * 512 + lanef * 8) = pack8(v);
                        } else {
                            bf16* base = (pn == 4) ? kvc : (kvc + (size_t)4 * S * 64);
                            *(u32x4*)(base + ((size_t)g * S + row) * 64 + d) = pack8(v);
                        }
                    }
                }
            }
    }
};
struct EpiMobaA {
    static constexpr bool PERM = true, AFTER_DRAIN = false;
    bf16* q; bf16* k; const float* tab;
    DI void operator()(const f32x4 (&acc)[2][2][4][2], const pg8::Unit& u, int wr, int wc, int fr, int fq) const {
        const int pn = u.pn;
        const bool rope = ((wc & 1) == 0);
#pragma unroll
        for (int ai = 0; ai < 2; ++ai)
#pragma unroll
            for (int m = 0; m < 4; ++m) {
                const int row = u.pm * 256 + ai * 128 + wr * 64 + m * 16 + fr;
#pragma unroll
                for (int bj = 0; bj < 2; ++bj) {
                    const int cb = bj * 128 + wc * 32 + 8 * fq;
                    float v[8];
#pragma unroll
                    for (int i = 0; i < 4; ++i) { v[i] = acc[ai][bj][m][0][i]; v[4 + i] = acc[ai][bj][m][1][i]; }
                    if (rope) rope8(v, tab + (size_t)row * 16, fq);
                    if (pn < 4) {
#pragma unroll
                        for (int i = 0; i < 8; ++i) v[i] *= QSCALE;
                        *(u32x4*)(q + (size_t)row * 1024 + pn * 256 + cb) = pack8(v);
                    } else {
                        const int h = (pn - 4) * 4 + (cb >> 6), d = cb & 63, kap = row & 31;
                        const int lanef = ((d & 31) >> 3) * 16 + 4 * (kap >> 3) + (kap & 3);
                        *(u32x4*)(k + (size_t)h * S * 64 + ((size_t)(((row >> 5) * 2 + ((kap >> 2) & 1)) * 2 + (d >> 5))) * 512 + lanef * 8) = pack8(v);
                    }
                }
            }
    }
};

struct EpiVfrag {
    static constexpr bool PERM = true, AFTER_DRAIN = false;
    bf16* vf;
    DI void operator()(const f32x4 (&acc)[2][2][4][2], const pg8::Unit& u, int wr, int wc, int fr, int fq) const {
#pragma unroll
        for (int ai = 0; ai < 2; ++ai)
#pragma unroll
            for (int m = 0; m < 4; ++m) {
                const int row = u.pm * 256 + ai * 128 + wr * 64 + m * 16 + fr;
                const int hh = row >> 6, dim = row & 63;
#pragma unroll
                for (int bj = 0; bj < 2; ++bj) {
                    const int t = u.pn * 256 + bj * 128 + wc * 32 + 8 * fq;
                    float v[8];
#pragma unroll
                    for (int i = 0; i < 4; ++i) { v[i] = acc[ai][bj][m][0][i]; v[4 + i] = acc[ai][bj][m][1][i]; }
                    const int lanef = ((t & 31) >> 3) * 16 + (dim & 15);
                    *(u32x4*)(vf + (size_t)hh * S * 64 + ((size_t)((t >> 5) * 4 + (dim >> 4))) * 512 + lanef * 8) = pack8(v);
                }
            }
    }
};
DI float gelu_tanh(float x) {
    const float u = 0.7978845608028654f * (x + 0.044715f * x * x * x);
    const float e = __expf(2.0f * u);
    const float t = 1.0f - 2.0f / (e + 1.0f);
    return 0.5f * x * (1.0f + t);
}
struct EpiCmp1 {
    static constexpr bool PERM = true, AFTER_DRAIN = false;
    bf16* H; const float* bias;
    DI void operator()(const f32x4 (&acc)[2][2][4][2], const pg8::Unit& u, int wr, int wc, int fr, int fq) const {
        const float* bb = bias + u.pn * 256;
#pragma unroll
        for (int ai = 0; ai < 2; ++ai)
#pragma unroll
            for (int m = 0; m < 4; ++m) {
                const int row = u.pm * 256 + ai * 128 + wr * 64 + m * 16 + fr;
#pragma unroll
                for (int bj = 0; bj < 2; ++bj) {
                    const int cb = bj * 128 + wc * 32 + 8 * fq;
                    const f32x4 b0 = *(const f32x4*)(bb + cb), b1 = *(const f32x4*)(bb + cb + 4);
                    float v[8];
#pragma unroll
                    for (int i = 0; i < 4; ++i) { v[i] = gelu_tanh(acc[ai][bj][m][0][i] + b0[i]); v[4 + i] = gelu_tanh(acc[ai][bj][m][1][i] + b1[i]); }
                    *(u32x4*)(H + (size_t)row * 256 + cb) = pack8(v);
                }
            }
    }
};
struct EpiResid {
    static constexpr bool PERM = false, AFTER_DRAIN = false;
    float* x;
    DI void operator()(const f32x4 (&acc)[2][2][4][2], const pg8::Unit& u, int wr, int wc, int fr, int fq) const {
#pragma unroll
        for (int ai = 0; ai < 2; ++ai)
#pragma unroll
            for (int m = 0; m < 4; ++m) {
                const int row = u.pm * 256 + ai * 128 + wr * 64 + m * 16 + fr;
                float* rp = x + (size_t)row * D + u.pn * 256 + wc * 32 + 4 * fq;
#pragma unroll
                for (int bj = 0; bj < 2; ++bj)
#pragma unroll
                    for (int n = 0; n < 2; ++n) {
                        f32x4* p = (f32x4*)(rp + bj * 128 + n * 16);
                        const f32x4 o = *p;
                        *p = o * ALPHA_F + acc[ai][bj][m][n];
                    }
            }
    }
};
struct EpiSwiglu {
    static constexpr bool PERM = true, AFTER_DRAIN = false;
    bf16* h;
    DI void operator()(const f32x4 (&acc)[2][2][4][2], const pg8::Unit& u, int wr, int wc, int fr, int fq) const {
#pragma unroll
        for (int ai = 0; ai < 2; ++ai)
#pragma unroll
            for (int m = 0; m < 4; ++m) {
                const int row = u.pm * 256 + ai * 128 + wr * 64 + m * 16 + fr;
                float v[8];
#pragma unroll
                for (int n = 0; n < 2; ++n)
#pragma unroll
                    for (int i = 0; i < 4; ++i) { const float g = acc[ai][0][m][n][i], uu = acc[ai][1][m][n][i]; v[4 * n + i] = g / (1.0f + __expf(-g)) * uu; }
                *(u32x4*)(h + (size_t)row * DFF + u.pn * 128 + wc * 32 + 8 * fq) = pack8(v);
            }
    }
};

DI void transpose_item(const float* W, int ldw, int ncols, bf16* WT, int ldt, int ilv, LAS float* scr, int item, int lane) {
    const int nblk = (ncols + 31) >> 5, kb = item / nblk, nb = item % nblk, k0 = 64 * kb, n0 = 32 * nb;
    const int cl = lane & 31; const bool cv = (n0 + cl) < ncols;
#pragma unroll 8
    for (int i = 0; i < 32; ++i) { const int kk = 2 * i + (lane >> 5); scr[kk * 33 + cl] = cv ? W[(size_t)(k0 + kk) * ldw + n0 + cl] : 0.f; }
    LDS_WAIT();
    const int c = lane & 7;
#pragma unroll
    for (int j = 0; j < 4; ++j) { const int n = (lane >> 3) + 8 * j; const LAS float* s = scr + (8 * c) * 33 + n;
        u32x4 o; o.x = cvtpk(s[0 * 33], s[1 * 33]); o.y = cvtpk(s[2 * 33], s[3 * 33]); o.z = cvtpk(s[4 * 33], s[5 * 33]); o.w = cvtpk(s[6 * 33], s[7 * 33]);
        const int ns = n0 + n; const int dr = ilv ? ((ns >> 7) * 256 + (ns & 127)) : ns;
        if (ns < ncols) *(u32x4*)(WT + (size_t)dr * ldt + k0 + 8 * c) = o; }
    LDS_WAIT();
}
struct ConvCtx { LAS float* scr; int gw, NGW, lane, base; };
DI void conv_job(ConvCtx& c, const float* W, int ldw, int K, int ncols, bf16* WT, int ldt, int ilv) {
    const int ni = (K / 64) * ((ncols + 31) >> 5);
    int first = c.gw - (c.base % c.NGW); if (first < 0) first += c.NGW;
    for (int it = first; it < ni; it += c.NGW) transpose_item(W, ldw, ncols, WT, ldt, ilv, c.scr, it, c.lane);
    c.base += ni;
}

DI void ln_row(float* xrow, bf16* brow, const float* gam, const float* bet, int lane) {
    f32x4* xr = (f32x4*)xrow + lane;
    f32x4 v[4]; float s = 0.f;
#pragma unroll
    for (int j = 0; j < 4; ++j) { v[j] = xr[64 * j]; s += (v[j][0] + v[j][1]) + (v[j][2] + v[j][3]); }
    const float mean = wave_sum(s) * (1.f / D); float s2 = 0.f;
#pragma unroll
    for (int j = 0; j < 4; ++j) { v[j] = v[j] - mean; s2 += (v[j][0] * v[j][0] + v[j][1] * v[j][1]) + (v[j][2] * v[j][2] + v[j][3] * v[j][3]); }
    const float rstd = 1.0f / sqrtf(wave_sum(s2) * (1.f / D) + LN_EPS);
#pragma unroll
    for (int j = 0; j < 4; ++j) {
        const f32x4 g = *((const f32x4*)gam + lane + 64 * j), b = *((const f32x4*)bet + lane + 64 * j);
        const f32x4 o = v[j] * rstd * g + b;
        xr[64 * j] = o;
        u32x2 w; w.x = cvtpk(o[0], o[1]); w.y = cvtpk(o[2], o[3]);
        *((u32x2*)brow + lane + 64 * j) = w;
    }
}

DI void sincos_d(double r, float& sn, float& cs) {
    const double z = r * r;
    double s = 1.0 / 15511210043330985984000000.0;
    s = s * z - 1.0 / 25852016738884976640000.0;
    s = s * z + 1.0 / 51090942171709440000.0;
    s = s * z - 1.0 / 121645100408832000.0;
    s = s * z + 1.0 / 355687428096000.0;
    s = s * z - 1.0 / 1307674368000.0;
    s = s * z + 1.0 / 6227020800.0;
    s = s * z - 1.0 / 39916800.0;
    s = s * z + 1.0 / 362880.0;
    s = s * z - 1.0 / 5040.0;
    s = s * z + 1.0 / 120.0;
    s = s * z - 1.0 / 6.0;
    s = s * z + 1.0;
    sn = (float)(s * r);
    double c = 1.0 / 620448401733239439360000.0;
    c = c * z - 1.0 / 1124000727777607680000.0;
    c = c * z + 1.0 / 2432902008176640000.0;
    c = c * z - 1.0 / 6402373705728000.0;
    c = c * z + 1.0 / 20922789888000.0;
    c = c * z - 1.0 / 87178291200.0;
    c = c * z + 1.0 / 479001600.0;
    c = c * z - 1.0 / 3628800.0;
    c = c * z + 1.0 / 40320.0;
    c = c * z - 1.0 / 720.0;
    c = c * z + 1.0 / 24.0;
    c = c * z - 0.5;
    c = c * z + 1.0;
    cs = (float)c;
}

DI float kg_allmax(float x) {
    auto r = __builtin_amdgcn_permlane16_swap(__float_as_uint(x), __float_as_uint(x), false, false);
    x = mx2(__uint_as_float(r[0]), __uint_as_float(r[1]));
    auto q = __builtin_amdgcn_permlane32_swap(__float_as_uint(x), __float_as_uint(x), false, false);
    return mx2(__uint_as_float(q[0]), __uint_as_float(q[1]));
}
DI float quad_sum(float v) { v += dppf<0xB1>(v); v += dppf<0x4E>(v); return v; }
DI float wave_allmax_f(float v) {
    v = mx2(v, dppf<0xB1>(v)); v = mx2(v, dppf<0x4E>(v)); v = mx2(v, dppf<0x141>(v)); v = mx2(v, dppf<0x140>(v));
    return kg_allmax(v);
}
DI unsigned wave_allmin_u(unsigned v) {
    v = min(v, dppu<0xB1>(v)); v = min(v, dppu<0x4E>(v)); v = min(v, dppu<0x141>(v)); v = min(v, dppu<0x140>(v));
    auto r = __builtin_amdgcn_permlane16_swap(v, v, false, false); v = min(r[0], r[1]);
    auto q = __builtin_amdgcn_permlane32_swap(v, v, false, false); return min(q[0], q[1]);
}
DI f32x4 sm_init(float m, bool colsel) { const float b = (m < -1e29f) ? 0.f : m; const float v = colsel ? -b : -INFINITY; return (f32x4){v, v, v, v}; }
DI int imax3(int a, int b, int c) { return max(max(a, b), c); }
template <int NS> DI void sm_stepN(f32x4 (&s)[NS][2], float& m, float& l, f32x4 (&O)[4], bf16x8 (&P)[NS], bool colsel = true) {
    int mi = (int)0x80000000;
#pragma unroll
    for (int t = 0; t < NS; ++t) {
        mi = imax3(mi, __float_as_int(s[t][0][0]), __float_as_int(s[t][0][1])); mi = imax3(mi, __float_as_int(s[t][0][2]), __float_as_int(s[t][0][3]));
        mi = imax3(mi, __float_as_int(s[t][1][0]), __float_as_int(s[t][1][1])); mi = imax3(mi, __float_as_int(s[t][1][2]), __float_as_int(s[t][1][3]));
    }
    const bool fresh = m < -1e29f;
    const bool trig = (mi > 0x41000000) || (fresh && colsel);
    if (__ballot(trig) != 0ull) {
        float mx = -INFINITY;
#pragma unroll
        for (int t = 0; t < NS; ++t)
#pragma unroll
            for (int i = 0; i < 4; ++i) mx = mx2(mx, mx2(s[t][0][i], s[t][1][i]));
        const float mxa = kg_allmax(mx);
        const bool none = !(mxa > -INFINITY);
        float mn = fresh ? mxa : mx2(mxa, 0.f);
        mn = (fresh && none) ? 0.f : mn;
        const float alpha = fresh ? 1.f : ex2(-mn);
        m = (fresh && none) ? m : ((fresh ? 0.f : m) + mn);
        l *= alpha;
#pragma unroll
        for (int dt = 0; dt < 4; ++dt) O[dt] = O[dt] * alpha;
#pragma unroll
        for (int t = 0; t < NS; ++t)
#pragma unroll
            for (int i = 0; i < 4; ++i) { s[t][0][i] -= mn; s[t][1][i] -= mn; }
    }
    float sum = 0.f;
#pragma unroll
    for (int t = 0; t < NS; ++t) {
        float p[8];
#pragma unroll
        for (int i = 0; i < 4; ++i) { p[i] = ex2(s[t][0][i]); p[4 + i] = ex2(s[t][1][i]); }
        sum += ((p[0] + p[1]) + (p[2] + p[3])) + ((p[4] + p[5]) + (p[6] + p[7]));
        u32x4 w; w.x = cvtpk(p[0], p[1]); w.y = cvtpk(p[2], p[3]); w.z = cvtpk(p[4], p[5]); w.w = cvtpk(p[6], p[7]);
        P[t] = __builtin_bit_cast(bf16x8, w);
    }
    l += sum;
}
DI bf16x8 sm_step(f32x4 s0, f32x4 s1, float& m, float& l, f32x4 (&O)[4]) {
    f32x4 s[1][2] = {{s0, s1}}; bf16x8 P[1]; sm_stepN<1>(s, m, l, O, P, true); return P[0];
}
DI void load_k(bf16x8 (&kA)[2][2], const bf16* K, int key0, int fr, int kg) {
    const bf16* p = K + (size_t)(key0 + 8 * (fr >> 2) + (fr & 3)) * 64 + 8 * kg;
    kA[0][0] = ldg8(p); kA[0][1] = ldg8(p + 32); kA[1][0] = ldg8(p + 4 * 64); kA[1][1] = ldg8(p + 4 * 64 + 32);
}
DI void load_vt(bf16x8 (&vA)[4], const bf16* VT, size_t ldv, int key0, int fr, int kg) {
    const bf16* p = VT + (size_t)fr * ldv + key0 + 8 * kg;
#pragma unroll
    for (int dt = 0; dt < 4; ++dt) vA[dt] = ldg8(p + (size_t)(16 * dt) * ldv);
}
DI void qk(f32x4& s0, f32x4& s1, const bf16x8 (&kA)[2][2], const bf16x8 (&qB)[2], const f32x4 z = {0.f, 0.f, 0.f, 0.f}) {
    s0 = MFMA16(kA[0][0], qB[0], z); s0 = MFMA16(kA[0][1], qB[1], s0);
    s1 = MFMA16(kA[1][0], qB[0], z); s1 = MFMA16(kA[1][1], qB[1], s1);
}


DI void gload_lds16(const bf16* g, LAS unsigned char* l) { __builtin_amdgcn_global_load_lds((const unsigned*)g, (LAS unsigned*)l, 16, 0, 0); }
DI void stage_chunk(LAS unsigned char* buf, const bf16* K, const bf16* VT, size_t ldv, int key0, int w, int lane) {
    const int b = 16 * lane, swz = b ^ (((b >> 9) & 1) << 5), rr = swz >> 6, cc = (swz & 63) >> 1;
    const int kb = key0 + 32 * w;
    LAS unsigned char* dst = buf + w * 8192;
    const bf16* kp = K + (size_t)(kb + 8 * (rr >> 2) + (rr & 3)) * 64 + cc;
    gload_lds16(kp, dst); gload_lds16(kp + 32, dst + 1024); gload_lds16(kp + 4 * 64, dst + 2048); gload_lds16(kp + 4 * 64 + 32, dst + 3072);
    const bf16* vp = VT + (size_t)rr * ldv + kb + cc;
#pragma unroll
    for (int dt = 0; dt < 4; ++dt) gload_lds16(vp + (size_t)(16 * dt) * ldv, dst + 4096 + dt * 1024);
}
DI void stage_half(LAS unsigned char* buf, const bf16* K, const bf16* VT, size_t ldv, int key0, int w, int lane) {
    const int b = 16 * lane, swz = b ^ (((b >> 9) & 1) << 5), rr = swz >> 6, cc = (swz & 63) >> 1;
    const int kb = key0 + 32 * (w >> 1);
    LAS unsigned char* dst = buf + (w >> 1) * 8192 + (w & 1) * 4096;
    if ((w & 1) == 0) {
        const bf16* kp = K + (size_t)(kb + 8 * (rr >> 2) + (rr & 3)) * 64 + cc;
        gload_lds16(kp, dst); gload_lds16(kp + 32, dst + 1024); gload_lds16(kp + 4 * 64, dst + 2048); gload_lds16(kp + 4 * 64 + 32, dst + 3072);
    } else {
        const bf16* vp = VT + (size_t)rr * ldv + kb + cc;
#pragma unroll
        for (int dt = 0; dt < 4; ++dt) gload_lds16(vp + (size_t)(16 * dt) * ldv, dst + dt * 1024);
    }
}
#define RAW_BARRIER() do { asm volatile("" ::: "memory"); __builtin_amdgcn_s_barrier(); asm volatile("" ::: "memory"); } while (0)
DI void stage_frag(LAS unsigned char* buf, const bf16* Kf, const bf16* Vf, size_t, int key0, int w, int lane) {
    const size_t so = (size_t)((key0 >> 5) + (w >> 1)) * 2048 + lane * 8;
    LAS unsigned char* dst = buf + (w >> 1) * 8192 + (w & 1) * 4096;
    const bf16* src = ((w & 1) == 0 ? Kf : Vf) + so;
#pragma unroll
    for (int f = 0; f < 4; ++f) gload_lds16(src + f * 512, dst + f * 1024);
}
DI int lds_roff(int fr, int kg) { const int ob = fr * 64 + kg * 16; return ob ^ (((ob >> 9) & 1) << 5); }
DI void lds_k(bf16x8 (&kA)[2][2], const LAS unsigned char* stp, int roff) {
    kA[0][0] = *(const LAS bf16x8*)(stp + roff); kA[0][1] = *(const LAS bf16x8*)(stp + 1024 + roff);
    kA[1][0] = *(const LAS bf16x8*)(stp + 2048 + roff); kA[1][1] = *(const LAS bf16x8*)(stp + 3072 + roff);
}
DI void lds_v(bf16x8 (&vA)[4], const LAS unsigned char* stp, int roff) {
#pragma unroll
    for (int dt = 0; dt < 4; ++dt) vA[dt] = *(const LAS bf16x8*)(stp + 4096 + dt * 1024 + roff);
}
#define VM_WAIT0() asm volatile("s_waitcnt vmcnt(0)" ::: "memory")

DI void load_kf(bf16x8 (&kA)[2][2], const bf16* Kf, int key0, int lane) {
    const bf16* p = Kf + (size_t)(key0 >> 5) * 2048 + lane * 8;
    kA[0][0] = ldg8(p); kA[0][1] = ldg8(p + 512); kA[1][0] = ldg8(p + 1024); kA[1][1] = ldg8(p + 1536);
}
DI void load_vf(bf16x8 (&vA)[4], const bf16* Vf, int key0, int lane) {
    const bf16* p = Vf + (size_t)(key0 >> 5) * 2048 + lane * 8;
#pragma unroll
    for (int dt = 0; dt < 4; ++dt) vA[dt] = ldg8(p + dt * 512);
}
DI void cp_k(bf16x8 (&d)[2][2], const bf16x8 (&a)[2][2]) { d[0][0] = a[0][0]; d[0][1] = a[0][1]; d[1][0] = a[1][0]; d[1][1] = a[1][1]; }
DI void cp_v(bf16x8 (&d)[4], const bf16x8 (&a)[4]) { d[0] = a[0]; d[1] = a[1]; d[2] = a[2]; d[3] = a[3]; }

#ifdef TIMING
DI unsigned rt_now() { return (unsigned)__builtin_amdgcn_s_memrealtime(); }
#define TSTART() unsigned t_last_ = rt_now()
#define TMARK(idx) do { const unsigned t_now_ = rt_now(); if (blockIdx.x == 0 && w == 0 && lane_id() == 0) atomicAdd(g_tim + (idx), (unsigned)(t_now_ - t_last_)); t_last_ = t_now_; } while (0)
#else
#define TSTART() do {} while (0)
#define TMARK(idx) do {} while (0)
#endif
struct NsaT { const bf16* q; const bf16* ksel; const bf16* kwin; const bf16* vselT; const bf16* vwinT; const bf16* kc; const bf16* vcT; const float* gates; bf16* o; f32x4* park; unsigned* g_tim; };

DI void nsa_unit(const NsaT& A, LAS unsigned char* lds, int T, int g, int w, int lane_in) {
    int lane = lane_id(); (void)lane_in;
    const int fr = lane & 15, kg = lane >> 4;
    const int t0 = T * 128 + w * 16;
    const int blk = t0 >> 6;
    unsigned* g_tim = A.g_tim; (void)g_tim; TSTART();
    LAS float* imp = (LAS float*)(lds) + w * 4096;
    LAS unsigned* sb = (LAS unsigned*)(lds + 131072) + w * 128;
    bf16x8 qB[4][2];
    int tqc[4];
    const int head = 4 * g + (fr & 3);
#pragma unroll
    for (int qd = 0; qd < 4; ++qd) {
        tqc[qd] = t0 + 4 * qd + (fr >> 2);
        const bf16* qp = A.q + (size_t)tqc[qd] * 1024 + head * 64 + 8 * kg;
        qB[qd][0] = ldg8(qp); qB[qd][1] = ldg8(qp + 32);
    }
    const f32x4 z4 = {0.f, 0.f, 0.f, 0.f};
    f32x4 Oc[4][4];
#pragma unroll
    for (int a = 0; a < 4; ++a)
#pragma unroll
        for (int b = 0; b < 4; ++b) Oc[a][b] = z4;
    const bf16* kc = A.kc + (size_t)g * 1024 * 64;
    const bf16* vcT = A.vcT + (size_t)g * 65536;
    const int ncmp = t0 >> 4;
    const int nst = (ncmp + 31) >> 5;
    if (blk > 15) {
#pragma unroll 4
        for (int i = 0; i < 64; ++i) imp[lane + 64 * i] = 0.f;
    }
    if (nst > 0) {
        int ln_ = lane; asm volatile("" : "+v"(ln_)); const int fr = ln_ & 15, kg = ln_ >> 4; (void)fr; (void)kg;
        float m1[4], l1[4]; int lim[4]; const int limlo = (t0 - 31) >> 4;
#pragma unroll
        for (int qd = 0; qd < 4; ++qd) { m1[qd] = -1e30f; l1[qd] = 0.f; lim[qd] = (tqc[qd] - 31) >> 4; }
        bf16x8 kP[2][2];
#ifdef DUP_CMP1
        for (int rep_ = 0; rep_ < 2; ++rep_) {
        float zf_ = 0.f; asm volatile("" : "+v"(zf_));
#pragma unroll
        for (int qd = 0; qd < 4; ++qd) { m1[qd] = m1[qd] * zf_ - 1e30f; l1[qd] = l1[qd] * zf_; }
#else
        {
#endif
        load_kf(kP, kc, 0, lane);
#pragma unroll 1
        for (int st = 0; st < nst; ++st) {
            const int n0 = 32 * st;
            bf16x8 kA[2][2]; cp_k(kA, kP);
            if (st + 1 < nst) load_kf(kP, kc, n0 + 32, lane);
#pragma unroll
            for (int qd = 0; qd < 4; ++qd) {
                const bool fresh = m1[qd] < -1e29f; const float base = fresh ? 0.f : m1[qd];
                f32x4 s0, s1; qk(s0, s1, kA, qB[qd], (f32x4){-base, -base, -base, -base});
                if (n0 + 31 > limlo) {
#pragma unroll
                    for (int i = 0; i < 4; ++i) {
                        s0[i] = (n0 + 8 * kg + i <= lim[qd]) ? s0[i] : -INFINITY;
                        s1[i] = (n0 + 8 * kg + 4 + i <= lim[qd]) ? s1[i] : -INFINITY;
                    }
                }
                int mi = imax3(__float_as_int(s0[0]), __float_as_int(s0[1]), __float_as_int(s0[2])); mi = imax3(mi, __float_as_int(s0[3]), __float_as_int(s1[0]));
                mi = imax3(mi, __float_as_int(s1[1]), __float_as_int(s1[2])); mi = max(mi, __float_as_int(s1[3]));
                if (__ballot((mi > 0x41000000) || fresh) != 0ull) {
                    float mx = -INFINITY;
#pragma unroll
                    for (int i = 0; i < 4; ++i) mx = mx2(mx, mx2(s0[i], s1[i]));
                    const bool none = !(mx > -INFINITY);
                    float mn = fresh ? mx : mx2(mx, 0.f);
                    mn = (fresh && none) ? 0.f : mn;
                    l1[qd] *= fresh ? 1.f : ex2(-mn);
                    m1[qd] = (fresh && none) ? m1[qd] : (base + mn);
#pragma unroll
                    for (int i = 0; i < 4; ++i) { s0[i] -= mn; s1[i] -= mn; }
                }
                float sum = 0.f;
#pragma unroll
                for (int i = 0; i < 4; ++i) sum += ex2(s0[i]) + ex2(s1[i]);
                l1[qd] += sum;
            }
        }
        }
        float inv[4];
#pragma unroll
        for (int qd = 0; qd < 4; ++qd) {
            const float mt = kg_allmax(m1[qd]);
            const float lt = kg_allsum(l1[qd] * ex2(m1[qd] - mt));
            m1[qd] = mt; inv[qd] = lt > 0.f ? 1.0f / lt : 0.f;
        }
        LDS_WAIT();
        load_kf(kP, kc, 0, lane);
        bf16x8 vP[4]; load_vf(vP, vcT, 0, lane);
#pragma unroll 1
        for (int st = 0; st < nst; ++st) {
            const int n0 = 32 * st;
            bf16x8 kA[2][2]; cp_k(kA, kP);
            bf16x8 vA[4]; cp_v(vA, vP);
            if (st + 1 < nst) { load_kf(kP, kc, n0 + 32, lane); load_vf(vP, vcT, n0 + 32, lane); }
#pragma unroll
            for (int qd = 0; qd < 4; ++qd) {
                const float b2_ = (m1[qd] < -1e29f) ? 0.f : -m1[qd];
                f32x4 s0, s1; qk(s0, s1, kA, qB[qd], (f32x4){b2_, b2_, b2_, b2_});
                float p[8];
#pragma unroll
                for (int i = 0; i < 4; ++i) { p[i] = ex2(s0[i]) * inv[qd]; p[4 + i] = ex2(s1[i]) * inv[qd]; }
                if (n0 + 31 > limlo) {
#pragma unroll
                    for (int i = 0; i < 4; ++i) {
                        p[i] = (n0 + 8 * kg + i <= lim[qd]) ? p[i] : 0.f;
                        p[4 + i] = (n0 + 8 * kg + 4 + i <= lim[qd]) ? p[4 + i] : 0.f;
                    }
                }
                u32x4 wv; wv.x = cvtpk(p[0], p[1]); wv.y = cvtpk(p[2], p[3]); wv.z = cvtpk(p[4], p[5]); wv.w = cvtpk(p[6], p[7]);
                const bf16x8 P = __builtin_bit_cast(bf16x8, wv);
#pragma unroll
                for (int dt = 0; dt < 4; ++dt) Oc[qd][dt] = MFMA16(vA[dt], P, Oc[qd][dt]);
                if (blk > 15) {
                    float a0 = 2.f * (p[0] + p[1] + p[2]) + p[3], b0 = p[3], a1 = 2.f * (p[4] + p[5] + p[6]) + p[7], b1 = p[7];
                    a0 = quad_sum(a0); b0 = quad_sum(b0); a1 = quad_sum(a1); b1 = quad_sum(b1);
                    if ((fr & 3) == 0) {
                        const int jb = (n0 >> 2) + 2 * kg;
                        LAS float* ip = imp + (4 * qd + (fr >> 2)) * 256 + jb;
                        __hip_atomic_fetch_add(ip, a0, __ATOMIC_RELAXED, __HIP_MEMORY_SCOPE_WORKGROUP);
                        __hip_atomic_fetch_add(ip + 1, b0 + a1, __ATOMIC_RELAXED, __HIP_MEMORY_SCOPE_WORKGROUP);
                        if (jb + 2 < 256) __hip_atomic_fetch_add(ip + 2, b1, __ATOMIC_RELAXED, __HIP_MEMORY_SCOPE_WORKGROUP);
                    }
                }
            }
        }
    }
    LDS_WAIT();
    TMARK(0);
#ifdef DUP_TOPK
    for (int rep_ = 0; rep_ < 2; ++rep_)
#endif
    if (blk <= 15) {
#pragma unroll
        for (int k = 0; k < 2; ++k) { const int idx = lane + 64 * k; sb[idx] = ((idx & 7) == 0) ? ((2u << blk) - 1u) : 0u; }
    } else {
#pragma unroll 1
        for (int q0 = 0; q0 < 16; q0 += 4) {
            float val[4][4]; unsigned myword[4];
#pragma unroll
            for (int u = 0; u < 4; ++u) { myword[u] = 0u;
#pragma unroll
                for (int i = 0; i < 4; ++i) { const int j = lane + 64 * i; const float v = imp[(q0 + u) * 256 + j]; val[u][i] = (j >= 1 && j <= blk - 2) ? v : -1.0f; } }
#pragma unroll 1
            for (int r = 0; r < 13; ++r) {
                float vb[4]; unsigned jm[4];
#pragma unroll
                for (int u = 0; u < 4; ++u) vb[u] = mx2(mx2(val[u][0], val[u][1]), mx2(val[u][2], val[u][3]));
#pragma unroll
                for (int u = 0; u < 4; ++u) vb[u] = wave_allmax_f(vb[u]);
#pragma unroll
                for (int u = 0; u < 4; ++u) { jm[u] = 0xffffu;
#pragma unroll
                    for (int i = 3; i >= 0; --i) jm[u] = (val[u][i] == vb[u]) ? (unsigned)(lane + 64 * i) : jm[u]; }
#pragma unroll
                for (int u = 0; u < 4; ++u) jm[u] = wave_allmin_u(jm[u]);
#pragma unroll
                for (int u = 0; u < 4; ++u) {
                    const int js = (int)jm[u];
#pragma unroll
                    for (int i = 0; i < 4; ++i) val[u][i] = (lane + 64 * i == js) ? -1.0f : val[u][i];
                    if ((js >> 5) == lane) myword[u] |= 1u << (js & 31);
                }
            }
            if (lane < 8) {
#pragma unroll
                for (int u = 0; u < 4; ++u) {
                    unsigned mw = myword[u];
                    if (lane == 0) mw |= 1u;
                    if (((blk - 1) >> 5) == lane) mw |= 1u << ((blk - 1) & 31);
                    if ((blk >> 5) == lane) mw |= 1u << (blk & 31);
                    sb[(q0 + u) * 8 + lane] = mw;
                }
            }
        }
    }
    TMARK(1);
    { int lp_ = lane; asm volatile("" : "+v"(lp_)); f32x4* park = A.park + ((size_t)((T * 4 + g) * 8 + w) * 16) * 64 + lp_;
#pragma unroll
    for (int qd = 0; qd < 4; ++qd) {
        const float g0 = A.gates[(size_t)tqc[qd] * 48 + 3 * head];
#pragma unroll
        for (int dt = 0; dt < 4; ++dt) park[(qd * 4 + dt) * 64] = Oc[qd][dt] * g0;
    }
    }
    f32x4 Ob[4][4]; float m2[4], l2[4];
#pragma unroll
    for (int a = 0; a < 4; ++a) { m2[a] = -1e30f; l2[a] = 0.f;
#pragma unroll
        for (int b = 0; b < 4; ++b) Ob[a][b] = z4; }
#ifdef DUP_SEL
    for (int rep_ = 0; rep_ < 2; ++rep_) {
    float zf_ = 0.f; asm volatile("" : "+v"(zf_));
#pragma unroll
    for (int a_ = 0; a_ < 4; ++a_) { m2[a_] = m2[a_] * zf_ - 1e30f; l2[a_] = l2[a_] * zf_;
#pragma unroll
        for (int b_ = 0; b_ < 4; ++b_) Ob[a_][b_] = Ob[a_][b_] * zf_; }
#else
    {
#endif
    __syncthreads();
    {
        int ln_ = lane; asm volatile("" : "+v"(ln_)); const int fr = ln_ & 15, kg = ln_ >> 4;
        const bf16* ks = A.ksel + (size_t)g * S * 64;
        const bf16* vsT = A.vselT + (size_t)g * 64 * S;
        const int nch = T + 1;
        const int roff = 16 * ln_;
        VM_WAIT0();
        stage_frag(lds, ks, vsT, S, 0, w, ln_);
        if (nch > 1) stage_frag(lds + 32768, ks, vsT, S, 128, w, ln_);
        if (nch > 2) stage_frag(lds + 65536, ks, vsT, S, 256, w, ln_);
        unsigned W = 0u;
#pragma unroll 1
        for (int c = 0; c < nch; ++c) {
            const int later = nch - 1 - c;
            if (later >= 2) asm volatile("s_waitcnt vmcnt(8)" ::: "memory"); else if (later == 1) asm volatile("s_waitcnt vmcnt(4)" ::: "memory"); else asm volatile("s_waitcnt vmcnt(0)" ::: "memory");
            RAW_BARRIER();
            if (c + 3 < nch) stage_frag(lds + ((c + 3) & 3) * 32768, ks, vsT, S, 128 * (c + 3), w, ln_);
            const LAS unsigned char* cb = lds + (c & 3) * 32768;
            if ((c & 15) == 0) W = (ln_ < 16) ? sb[ln_ * 8 + (c >> 4)] : 0u;
#pragma unroll 1
            for (int jj = 0; jj < 2; ++jj) {
                const int j = 2 * c + jj;
                if (j > blk) break;
                const unsigned m16 = (unsigned)__ballot((W >> (j & 31)) & 1u);
                if (m16 == 0u) continue;
                {
                    const int key0 = 64 * j;
                    const LAS unsigned char* stp = cb + (2 * jj) * 8192;
                    bf16x8 kA[2][2][2], vA[2][4];
                    lds_k(kA[0], stp, roff); lds_k(kA[1], stp + 8192, roff);
                    lds_v(vA[0], stp, roff); lds_v(vA[1], stp + 8192, roff);
#pragma unroll
                    for (int qd = 0; qd < 4; ++qd) {
                        const unsigned qm = (m16 >> (4 * qd)) & 0xfu;
                        if (qm == 0u) continue;
                        const bool colsel = (qm >> (fr >> 2)) & 1u;
                        const f32x4 ini = sm_init(m2[qd], colsel);
                        f32x4 sc[2][2];
                        qk(sc[0][0], sc[0][1], kA[0], qB[qd], ini); qk(sc[1][0], sc[1][1], kA[1], qB[qd], ini);
                        if (j == blk) {
#pragma unroll
                            for (int t = 0; t < 2; ++t)
#pragma unroll
                                for (int i = 0; i < 4; ++i) {
                                    sc[t][0][i] = (key0 + 32 * t + 8 * kg + i <= tqc[qd]) ? sc[t][0][i] : -INFINITY;
                                    sc[t][1][i] = (key0 + 32 * t + 8 * kg + 4 + i <= tqc[qd]) ? sc[t][1][i] : -INFINITY;
                                }
                        }
                        bf16x8 P[2]; sm_stepN<2>(sc, m2[qd], l2[qd], Ob[qd], P, colsel);
#pragma unroll
                        for (int dt = 0; dt < 4; ++dt) { Ob[qd][dt] = MFMA16(vA[0][dt], P[0], Ob[qd][dt]); Ob[qd][dt] = MFMA16(vA[1][dt], P[1], Ob[qd][dt]); }
                    }
                }
            }
        }
        __syncthreads();
    }
    }
    TMARK(2);
    float g2w[4];
    { int lp_ = lane; asm volatile("" : "+v"(lp_)); f32x4* park = A.park + ((size_t)((T * 4 + g) * 8 + w) * 16) * 64 + lp_;
#pragma unroll
    for (int qd = 0; qd < 4; ++qd) {
        const float* gp = A.gates + (size_t)tqc[qd] * 48 + 3 * head;
        const float g1 = gp[1]; g2w[qd] = gp[2];
        const float lt = kg_allsum(l2[qd]);
        const float c1 = lt > 0.f ? g1 / lt : 0.f;
#pragma unroll
        for (int dt = 0; dt < 4; ++dt) { park[(qd * 4 + dt) * 64] = park[(qd * 4 + dt) * 64] + Ob[qd][dt] * c1; Ob[qd][dt] = z4; }
        m2[qd] = -1e30f; l2[qd] = 0.f;
    }
    }
#ifdef DUP_WIN
    for (int rep_ = 0; rep_ < 2; ++rep_) {
    float zf_ = 0.f; asm volatile("" : "+v"(zf_));
#pragma unroll
    for (int a_ = 0; a_ < 4; ++a_) { m2[a_] = m2[a_] * zf_ - 1e30f; l2[a_] = l2[a_] * zf_;
#pragma unroll
        for (int b_ = 0; b_ < 4; ++b_) Ob[a_][b_] = Ob[a_][b_] * zf_; }
#else
    {
#endif
    {
        int ln_ = lane; asm volatile("" : "+v"(ln_)); const int fr = ln_ & 15, kg = ln_ >> 4; (void)fr; (void)kg;
        const bf16* kw = A.kwin + (size_t)g * S * 64;
        const bf16* vwT = A.vwinT + (size_t)g * 64 * S;
        int klo = t0 - 511; klo = klo < 0 ? 0 : klo; klo &= ~31;
        const int khi = (t0 + 15) & ~31;
        bf16x8 kP[2][2], vP[4]; load_kf(kP, kw, klo, ln_); load_vf(vP, vwT, klo, ln_);
#pragma unroll 1
        for (int key0 = klo; key0 <= khi; key0 += 32) {
            bf16x8 kA[2][2]; cp_k(kA, kP);
            bf16x8 vA[4]; cp_v(vA, vP);
            if (key0 + 32 <= khi) { load_kf(kP, kw, key0 + 32, ln_); load_vf(vP, vwT, key0 + 32, ln_); }
            const bool needmask = (key0 + 31 > t0) || (key0 < t0 + 15 - 511);
#pragma unroll
            for (int qd = 0; qd < 4; ++qd) {
                f32x4 s0, s1; qk(s0, s1, kA, qB[qd], sm_init(m2[qd], true));
                if (needmask) {
#pragma unroll
                    for (int i = 0; i < 4; ++i) {
                        const int k0 = key0 + 8 * kg + i, k1 = k0 + 4;
                        s0[i] = (k0 <= tqc[qd] && k0 >= tqc[qd] - 511) ? s0[i] : -INFINITY;
                        s1[i] = (k1 <= tqc[qd] && k1 >= tqc[qd] - 511) ? s1[i] : -INFINITY;
                    }
                }
                const bf16x8 P = sm_step(s0, s1, m2[qd], l2[qd], Ob[qd]);
#pragma unroll
                for (int dt = 0; dt < 4; ++dt) Ob[qd][dt] = MFMA16(vA[dt], P, Ob[qd][dt]);
            }
        }
    }
    }
    int lf_ = lane; asm volatile("" : "+v"(lf_));
    f32x4* park = A.park + ((size_t)((T * 4 + g) * 8 + w) * 16) * 64 + lf_;
#pragma unroll
    for (int qd = 0; qd < 4; ++qd) {
        const float lt = kg_allsum(l2[qd]);
        const float c2 = lt > 0.f ? g2w[qd] / lt : 0.f;
        bf16* op = A.o + (size_t)(t0 + 4 * qd + ((lf_ & 15) >> 2)) * 1024 + (4 * g + (lf_ & 3)) * 64 + 4 * (lf_ >> 4);
#pragma unroll
        for (int dt = 0; dt < 4; ++dt) {
            const f32x4 o = park[(qd * 4 + dt) * 64] + Ob[qd][dt] * c2;
            u32x2 wv; wv.x = cvtpk(o[0], o[1]); wv.y = cvtpk(o[2], o[3]);
            *(u32x2*)(op + 16 * dt) = wv;
        }
    }
    TMARK(3);
}

struct MobaT { const bf16* q; const bf16* k; const bf16* vT; const bf16* kmh; const bf16* kml; bf16* o; unsigned* g_tim; };
DI void ins3(u64 x, u64& k1, u64& k2, u64& k3) {
    const bool g1 = x > k1, g2 = x > k2, g3 = x > k3;
    const u64 n3 = g2 ? k2 : (g3 ? x : k3), n2 = g1 ? k1 : (g2 ? x : k2), n1 = g1 ? x : k1;
    k1 = n1; k2 = n2; k3 = n3;
}
DI void moba_unit(const MobaT& A, LAS unsigned char* lds, int h, int U, int w, int lane_in) {
    int lane = lane_id(); (void)lane_in;
    const int fr = lane & 15, kg = lane >> 4;
    const int t0 = U * 512 + w * 64;
    const int cur = t0 >> 8;
    bf16x8 qB[4][2]; int tqc[4];
#pragma unroll
    for (int nt = 0; nt < 4; ++nt) {
        tqc[nt] = t0 + 16 * nt + fr;
        const bf16* qp = A.q + (size_t)tqc[nt] * 1024 + h * 64 + 8 * kg;
        qB[nt][0] = ldg8(qp); qB[nt][1] = ldg8(qp + 32);
    }
    const f32x4 z4 = {0.f, 0.f, 0.f, 0.f};
    u64 selm[4] = {0ull, 0ull, 0ull, 0ull};
    if (cur > 0) {
        const int nmt = (cur + 15) >> 4;
        u64 k1[4], k2[4], k3[4];
#pragma unroll
        for (int nt = 0; nt < 4; ++nt) { k1[nt] = 0ull; k2[nt] = 0ull; k3[nt] = 0ull; }
        for (int mt = 0; mt < nmt; ++mt) {
            const size_t off = ((size_t)(h * 64 + 16 * mt + fr)) * 64 + 8 * kg;
            const bf16x8 ah0 = ldg8(A.kmh + off), ah1 = ldg8(A.kmh + off + 32), al0 = ldg8(A.kml + off), al1 = ldg8(A.kml + off + 32);
#pragma unroll
            for (int nt = 0; nt < 4; ++nt) {
                f32x4 s = MFMA16(ah0, qB[nt][0], z4); s = MFMA16(ah1, qB[nt][1], s); s = MFMA16(al0, qB[nt][0], s); s = MFMA16(al1, qB[nt][1], s);
#pragma unroll
                for (int i = 0; i < 4; ++i) {
                    const int b = 16 * mt + 4 * kg + i;
                    unsigned ub = __float_as_uint(s[i]); ub = (ub & 0x80000000u) ? ~ub : (ub | 0x80000000u);
                    const u64 x = (b < cur) ? (((u64)ub << 32) | (u64)(63 - b)) : 0ull;
                    ins3(x, k1[nt], k2[nt], k3[nt]);
                }
            }
        }
#pragma unroll
        for (int nt = 0; nt < 4; ++nt) {
            { const u64 p1 = x16q(k1[nt], kg), p2 = x16q(k2[nt], kg), p3 = x16q(k3[nt], kg); ins3(p1, k1[nt], k2[nt], k3[nt]); ins3(p2, k1[nt], k2[nt], k3[nt]); ins3(p3, k1[nt], k2[nt], k3[nt]); }
            { const u64 p1 = x32q(k1[nt], kg), p2 = x32q(k2[nt], kg), p3 = x32q(k3[nt], kg); ins3(p1, k1[nt], k2[nt], k3[nt]); ins3(p2, k1[nt], k2[nt], k3[nt]); ins3(p3, k1[nt], k2[nt], k3[nt]); }
            u64 sm = 0ull;
            if (k1[nt]) sm |= 1ull << (63 - (int)(k1[nt] & 63ull));
            if (k2[nt]) sm |= 1ull << (63 - (int)(k2[nt] & 63ull));
            if (k3[nt]) sm |= 1ull << (63 - (int)(k3[nt] & 63ull));
            selm[nt] = sm;
        }
    }
    f32x4 O[4][4]; float m[4], l[4];
#pragma unroll
    for (int a = 0; a < 4; ++a) { m[a] = -1e30f; l[a] = 0.f;
#pragma unroll
        for (int b = 0; b < 4; ++b) O[a][b] = z4; }
    const bf16* K = A.k + (size_t)h * S * 64;
    const bf16* VT = A.vT + (size_t)h * 64 * S;
    {
        const int nch = 2 * U + 2;
        const int roff = lds_roff(fr, kg);
        stage_chunk(lds, K, VT, S, 0, w, lane);
#pragma unroll 1
        for (int c = 0; c < nch; ++c) {
            VM_WAIT0(); __syncthreads();
            if (c + 1 < nch) stage_chunk(lds + ((c + 1) & 1) * 65536, K, VT, S, 256 * (c + 1), w, lane);
            const LAS unsigned char* cb = lds + (c & 1) * 65536;
            if (c < cur) {
                bool act[4]; bool any = false;
#pragma unroll
                for (int nt = 0; nt < 4; ++nt) { act[nt] = __ballot((selm[nt] >> c) & 1ull) != 0ull; any = any || act[nt]; }
                if (any) {
#pragma unroll 1
                    for (int st = 0; st < 8; st += 2) {
                        bf16x8 kA[2][2][2], vA[2][4];
                        lds_k(kA[0], cb + st * 8192, roff); lds_k(kA[1], cb + st * 8192 + 8192, roff);
                        lds_v(vA[0], cb + st * 8192, roff); lds_v(vA[1], cb + st * 8192 + 8192, roff);
#pragma unroll
                        for (int nt = 0; nt < 4; ++nt) {
                            if (!act[nt]) continue;
                            const bool colsel = (selm[nt] >> c) & 1ull;
                            const f32x4 ini = sm_init(m[nt], colsel);
                            f32x4 sc[2][2];
                            qk(sc[0][0], sc[0][1], kA[0], qB[nt], ini); qk(sc[1][0], sc[1][1], kA[1], qB[nt], ini);
                            bf16x8 P[2]; sm_stepN<2>(sc, m[nt], l[nt], O[nt], P, colsel);
#pragma unroll
                            for (int dt = 0; dt < 4; ++dt) { O[nt][dt] = MFMA16(vA[0][dt], P[0], O[nt][dt]); O[nt][dt] = MFMA16(vA[1][dt], P[1], O[nt][dt]); }
                        }
                    }
                }
            } else if (c == cur) {
#pragma unroll 1
                for (int key0 = 256 * cur; key0 <= t0 + 32; key0 += 32) {
                    const int st = (key0 - 256 * cur) >> 5;
                    bf16x8 kA[2][2]; lds_k(kA, cb + st * 8192, roff);
                    bf16x8 vA[4]; lds_v(vA, cb + st * 8192, roff);
#pragma unroll
                    for (int nt = 0; nt < 4; ++nt) {
                        if (key0 > t0 + 16 * nt + 15) continue;
                        f32x4 s0, s1; qk(s0, s1, kA, qB[nt], sm_init(m[nt], true));
                        if (key0 + 31 > t0 + 16 * nt) {
#pragma unroll
                            for (int i = 0; i < 4; ++i) {
                                s0[i] = (key0 + 8 * kg + i <= tqc[nt]) ? s0[i] : -INFINITY;
                                s1[i] = (key0 + 8 * kg + 4 + i <= tqc[nt]) ? s1[i] : -INFINITY;
                            }
                        }
                        const bf16x8 P = sm_step(s0, s1, m[nt], l[nt], O[nt]);
#pragma unroll
                        for (int dt = 0; dt < 4; ++dt) O[nt][dt] = MFMA16(vA[dt], P, O[nt][dt]);
                    }
                }
            }
        }
        __syncthreads();
    }
#pragma unroll
    for (int nt = 0; nt < 4; ++nt) {
        const float lt = kg_allsum(l[nt]);
        const float c = lt > 0.f ? 1.0f / lt : 0.f;
        int l2_ = lane; asm volatile("" : "+v"(l2_));
        bf16* op = A.o + (size_t)(t0 + 16 * nt + (l2_ & 15)) * 1024 + h * 64 + 4 * (l2_ >> 4);
#pragma unroll
        for (int dt = 0; dt < 4; ++dt) {
            const f32x4 o = O[nt][dt] * c;
            u32x2 wv; wv.x = cvtpk(o[0], o[1]); wv.y = cvtpk(o[2], o[3]);
            *(u32x2*)(op + 16 * dt) = wv;
        }
    }
}


DI void moba_unit2(const MobaT& A, LAS unsigned char* lds, int h, int QB, int w) {
    const int lane = lane_id(); const int fr = lane & 15, kg = lane >> 4;
    LAS unsigned char* part = lds;
    LAS unsigned short* list = (LAS unsigned short*)(lds + 104448);
    LAS unsigned* cnt = (LAS unsigned*)(lds + 137216);
    const int cur = QB, tb = QB * 256;
    const f32x4 z4 = {0.f, 0.f, 0.f, 0.f};
    const bf16* K = A.k + (size_t)h * S * 64;
    const bf16* VT = A.vT + (size_t)h * 64 * S;
    float NEG30 = -1e30f; asm volatile("" : "+v"(NEG30));
    unsigned* g_tim = A.g_tim; (void)g_tim; TSTART();
    if (w == 0) cnt[lane] = 0u;
    __syncthreads();
#pragma unroll 1
    for (int nt = 0; nt < 2; ++nt) {
        const int ql = 32 * w + 16 * nt + fr;
        const bf16* qp = A.q + (size_t)(tb + ql) * 1024 + h * 64 + 8 * kg;
        const bf16x8 q0 = ldg8(qp), q1 = ldg8(qp + 32);
        u64 k1 = 0ull, k2 = 0ull, k3 = 0ull;
        const int nmt = (cur + 15) >> 4;
#pragma unroll 1
        for (int mt = 0; mt < nmt; ++mt) {
            const size_t off = ((size_t)(h * 64 + 16 * mt + fr)) * 64 + 8 * kg;
            const bf16x8 ah0 = ldg8(A.kmh + off), ah1 = ldg8(A.kmh + off + 32), al0 = ldg8(A.kml + off), al1 = ldg8(A.kml + off + 32);
            f32x4 sc = MFMA16(ah0, q0, z4); sc = MFMA16(ah1, q1, sc); sc = MFMA16(al0, q0, sc); sc = MFMA16(al1, q1, sc);
#pragma unroll
            for (int i = 0; i < 4; ++i) {
                const int b = 16 * mt + 4 * kg + i;
                unsigned ub = __float_as_uint(sc[i]); ub = (ub & 0x80000000u) ? ~ub : (ub | 0x80000000u);
                const u64 x = (b < cur) ? (((u64)ub << 32) | (u64)(63 - b)) : 0ull;
                ins3(x, k1, k2, k3);
            }
        }
        { const u64 p1 = x16q(k1, kg), p2 = x16q(k2, kg), p3 = x16q(k3, kg); ins3(p1, k1, k2, k3); ins3(p2, k1, k2, k3); ins3(p3, k1, k2, k3); }
        { const u64 p1 = x32q(k1, kg), p2 = x32q(k2, kg), p3 = x32q(k3, kg); ins3(p1, k1, k2, k3); ins3(p2, k1, k2, k3); ins3(p3, k1, k2, k3); }
        if (kg == 0) {
#pragma unroll
            for (int sl = 0; sl < 3; ++sl) {
                const u64 ks = sl == 0 ? k1 : sl == 1 ? k2 : k3;
                LAS unsigned char* ps = part + (ql * 3 + sl) * 136;
                if (ks != 0ull) {
                    const int b = 63 - (int)(ks & 63ull);
                    const unsigned pos = __hip_atomic_fetch_add(cnt + b, 1u, __ATOMIC_RELAXED, __HIP_MEMORY_SCOPE_WORKGROUP);
                    list[b * 256 + pos] = (unsigned short)(ql | (sl << 8));
                } else {
                    unsigned zz = 0u; asm volatile("" : "+v"(zz));
#pragma unroll
                    for (int i = 0; i < 16; ++i) *(LAS u32x2*)(ps + 8 * i) = (u32x2){zz, zz};
                    *(LAS float*)(ps + 128) = NEG30; *(LAS float*)(ps + 132) = __uint_as_float(zz);
                }
            }
        }
    }
    __syncthreads();
    TMARK(4);
#ifdef DUP_M2
    for (int rep_ = 0; rep_ < 2; ++rep_)
#endif
#pragma unroll 1
    for (int b = w; b < cur; b += 8) {
        const int n = (int)__builtin_amdgcn_readfirstlane(cnt[b]);
#pragma unroll 1
        for (int e0 = 0; e0 < n; e0 += 16) {
            const bool valid = (e0 + fr) < n;
            const unsigned e = list[b * 256 + (valid ? e0 + fr : 0)];
            const int ql = e & 255, sl = e >> 8;
            const bf16* qp = A.q + (size_t)(tb + ql) * 1024 + h * 64 + 8 * kg;
            bf16x8 qB[2]; qB[0] = ldg8(qp); qB[1] = ldg8(qp + 32);
            float m = NEG30, l = 0.f; f32x4 O[4] = {z4, z4, z4, z4};
            bf16x8 kA[2][2][2], vA[2][4];
            load_kf(kA[0], K, 256 * b, lane); load_kf(kA[1], K, 256 * b + 32, lane);
            load_vf(vA[0], VT, 256 * b, lane); load_vf(vA[1], VT, 256 * b + 32, lane);
#pragma unroll
            for (int it = 0; it < 4; ++it) {
                bf16x8 kN[2][2][2], vN[2][4];
                if (it < 3) {
                    const int kn = 256 * b + 64 * (it + 1);
                    load_kf(kN[0], K, kn, lane); load_kf(kN[1], K, kn + 32, lane);
                    load_vf(vN[0], VT, kn, lane); load_vf(vN[1], VT, kn + 32, lane);
                }
                const f32x4 ini = sm_init(m, true);
                f32x4 sc[2][2];
                qk(sc[0][0], sc[0][1], kA[0], qB, ini); qk(sc[1][0], sc[1][1], kA[1], qB, ini);
                bf16x8 P[2]; sm_stepN<2>(sc, m, l, O, P);
#pragma unroll
                for (int dt = 0; dt < 4; ++dt) { O[dt] = MFMA16(vA[0][dt], P[0], O[dt]); O[dt] = MFMA16(vA[1][dt], P[1], O[dt]); }
                if (it < 3) {
#pragma unroll
                    for (int a = 0; a < 2; ++a) {
#pragma unroll
                        for (int hh = 0; hh < 2; ++hh) { kA[a][hh][0] = kN[a][hh][0]; kA[a][hh][1] = kN[a][hh][1]; }
#pragma unroll
                        for (int dt = 0; dt < 4; ++dt) vA[a][dt] = vN[a][dt];
                    }
                }
                __builtin_amdgcn_sched_barrier(0);
            }
            const float lt = kg_allsum(l);
            if (valid) {
                LAS unsigned char* ps = part + (ql * 3 + sl) * 136;
#pragma unroll
                for (int dt = 0; dt < 4; ++dt) { u32x2 wv; wv.x = cvtpk(O[dt][0], O[dt][1]); wv.y = cvtpk(O[dt][2], O[dt][3]); *(LAS u32x2*)(ps + (16 * dt + 4 * kg) * 2) = wv; }
                if (kg == 0) { *(LAS float*)(ps + 128) = m; *(LAS float*)(ps + 132) = lt; }
            }
        }
    }
    __syncthreads();
    TMARK(5);
#ifdef DUP_M3
    for (int rep_ = 0; rep_ < 2; ++rep_)
#endif
    {
        const int lane3 = lane_id(); const int fr = lane3 & 15, kg = lane3 >> 4;
        bf16x8 qB[2][2]; int tq[2];
#pragma unroll
        for (int nt = 0; nt < 2; ++nt) {
            tq[nt] = tb + 32 * w + 16 * nt + fr;
            const bf16* qp = A.q + (size_t)tq[nt] * 1024 + h * 64 + 8 * kg;
            qB[nt][0] = ldg8(qp); qB[nt][1] = ldg8(qp + 32);
        }
        float m[2] = {NEG30, NEG30}, l[2] = {0.f, 0.f}; f32x4 O[2][4] = {{z4, z4, z4, z4}, {z4, z4, z4, z4}};
        const int t0w = tb + 32 * w;
#pragma unroll 1
        for (int key0 = tb; key0 <= t0w + 31; key0 += 32) {
            bf16x8 kA[2][2]; load_kf(kA, K, key0, lane3);
            bf16x8 vA[4]; load_vf(vA, VT, key0, lane3);
#pragma unroll
            for (int nt = 0; nt < 2; ++nt) {
                if (key0 > t0w + 16 * nt + 15) continue;
                f32x4 s0, s1; qk(s0, s1, kA, qB[nt], sm_init(m[nt], true));
                if (key0 + 31 > t0w + 16 * nt) {
#pragma unroll
                    for (int i = 0; i < 4; ++i) {
                        s0[i] = (key0 + 8 * kg + i <= tq[nt]) ? s0[i] : -INFINITY;
                        s1[i] = (key0 + 8 * kg + 4 + i <= tq[nt]) ? s1[i] : -INFINITY;
                    }
                }
                const bf16x8 P = sm_step(s0, s1, m[nt], l[nt], O[nt]);
#pragma unroll
                for (int dt = 0; dt < 4; ++dt) O[nt][dt] = MFMA16(vA[dt], P, O[nt][dt]);
            }
        }
#pragma unroll
        for (int nt = 0; nt < 2; ++nt) {
            float lt = kg_allsum(l[nt]); float mm = m[nt];
            const int ql = 32 * w + 16 * nt + fr;
#pragma unroll
            for (int sl = 0; sl < 3; ++sl) {
                const LAS unsigned char* ps = part + (ql * 3 + sl) * 136;
                const float ms = *(const LAS float*)(ps + 128), ls = *(const LAS float*)(ps + 132);
                const float mn = mx2(mm, ms), a = ex2(mm - mn), bsc = ex2(ms - mn);
                lt = lt * a + ls * bsc; mm = mn;
#pragma unroll
                for (int dt = 0; dt < 4; ++dt) {
                    const u32x2 wv = *(const LAS u32x2*)(ps + (16 * dt + 4 * kg) * 2);
                    const f32x4 os = {__uint_as_float(wv.x << 16), __uint_as_float(wv.x & 0xffff0000u), __uint_as_float(wv.y << 16), __uint_as_float(wv.y & 0xffff0000u)};
                    O[nt][dt] = O[nt][dt] * a + os * bsc;
                }
            }
            const float c = lt > 0.f ? 1.0f / lt : 0.f;
            bf16* op = A.o + (size_t)tq[nt] * 1024 + h * 64 + 4 * kg;
#pragma unroll
            for (int dt = 0; dt < 4; ++dt) {
                const f32x4 o = O[nt][dt] * c;
                u32x2 wv; wv.x = cvtpk(o[0], o[1]); wv.y = cvtpk(o[2], o[3]);
                *(u32x2*)(op + 16 * dt) = wv;
            }
        }
    }
    __syncthreads();
    TMARK(6);
}

__global__ void __launch_bounds__(NTHR, 2) trunk_fwd(Args args) {
    extern __shared__ __attribute__((aligned(16))) unsigned char lds_raw[];
    LAS unsigned char* lds = (LAS unsigned char*)lds_raw;
    cg::grid_group grid = cg::this_grid();
    const int wave_s = __builtin_amdgcn_readfirstlane(threadIdx.x >> 6);
    if (threadIdx.x < 16) ((LAS unsigned*)(lds + 140000))[threadIdx.x] = 0u;
    __syncthreads();
    XcdBarrier xbar = xcd_barrier_post((unsigned*)args.ws + 4096, (volatile LAS unsigned*)(lds + 140000));
    xbar.w0 = (wave_s == 0);
    bool first_sync = true;
#ifdef TIMING
    unsigned tk_last = (unsigned)__builtin_amdgcn_s_memrealtime(); const unsigned tk_begin = tk_last;
#define PH(idx) do { const unsigned t_ = (unsigned)__builtin_amdgcn_s_memrealtime(); if (blockIdx.x == 0 && wave_s == 0 && lane_id() == 0) atomicAdd((unsigned*)(args.ws + 65536) + (idx), (unsigned)(t_ - tk_last)); tk_last = t_; } while (0)
#else
#define PH(idx) do {} while (0)
#endif
#define GRID_SYNC() do { if (first_sync) { grid.sync(); first_sync = false; } else xcd_barrier(xbar); } while (0)
    const int G = gridDim.x, bx = blockIdx.x, NGW = G * NWAVES;
#define FRESH_Z() ({ size_t z_ = 0; asm volatile("" : "+s"(z_)); z_; })
#define FRESH_WS() (args.ws + FRESH_Z())
#define FRESH_X() (args.out + FRESH_Z())
#define FRESH_IN(i) (args.in[i] + FRESH_Z())
#define PTRS() int tid = wave_s * 64 + lane_id(); asm volatile("" : "+v"(tid)); const int lane = tid & 63, wave = __builtin_amdgcn_readfirstlane(tid >> 6), gw = bx * NWAVES + wave; (void)lane; (void)gw; \
    unsigned char* ws = FRESH_WS(); float* X = FRESH_X(); \
    bf16* XB = (bf16*)(ws + WS_XB); float* TAB = (float*)(ws + WS_TAB); float* BIAS = (float*)(ws + WS_BIAS); \
    bf16* KMH = (bf16*)(ws + WS_KMEAN); bf16* KML = KMH + 16 * 64 * 64; \
    bf16* WA = (bf16*)(ws + WS_WA); bf16* WVT = (bf16*)(ws + WS_WVT); bf16* WO = (bf16*)(ws + WS_WO); \
    bf16* WC1 = (bf16*)(ws + WS_WC1); bf16* WC2 = (bf16*)(ws + WS_WC2); bf16* WGU = (bf16*)(ws + WS_WGU); bf16* WD = (bf16*)(ws + WS_WD); \
    bf16* Qb = (bf16*)(ws + WS_Q); bf16* Ob = (bf16*)(ws + WS_O); \
    bf16* KVC = (bf16*)(ws + WS_KVC); bf16* KSEL = (bf16*)(ws + WS_KSEL); bf16* KWIN = (bf16*)(ws + WS_KWIN); bf16* VSELT = (bf16*)(ws + WS_VSELT); \
    float* GATES = (float*)(ws + WS_GATES); bf16* HC = (bf16*)(ws + WS_HC); bf16* KC = (bf16*)(ws + WS_KC); bf16* VCT = (bf16*)(ws + WS_VCT); \
    bf16* MK = (bf16*)(ws + WS_MK); bf16* MVT = (bf16*)(ws + WS_MVT); bf16* HB = (bf16*)(ws + WS_H); \
    (void)X; (void)XB; (void)TAB; (void)BIAS; (void)KMH; (void)KML; (void)WA; (void)WVT; (void)WO; (void)WC1; (void)WC2; (void)WGU; (void)WD; (void)Qb; (void)Ob; \
    (void)KVC; (void)KSEL; (void)KWIN; (void)VSELT; (void)GATES; (void)HC; (void)KC; (void)VCT; (void)MK; (void)MVT; (void)HB;
    {
        PTRS();
        const f32x4* x4 = (const f32x4*)FRESH_IN(0); f32x4* o4 = (f32x4*)X; u32x2* b2 = (u32x2*)XB;
        for (size_t i = (size_t)bx * NTHR + tid; i < (size_t)S * D / 4; i += (size_t)G * NTHR) {
            const f32x4 v = x4[i]; o4[i] = v; u32x2 w; w.x = cvtpk(v[0], v[1]); w.y = cvtpk(v[2], v[3]); b2[i] = w; }
        for (int i = bx * NTHR + tid; i < S * 8; i += G * NTHR) {
            const int t = i >> 3, f = i & 7;
            const float invf = f == 0 ? 1.0f : f == 1 ? 0.19392274f : f == 2 ? 0.03760603f : f == 3 ? 0.0072926646f : f == 4 ? 0.0014142136f : f == 5 ? 0.0002742482f : f == 6 ? 5.3182957e-05f : 1.0313385e-05f;
            const float ang = (float)args.pos[t] * invf;
            const double a = (double)ang, k = __builtin_rint(a * 0.15915494309189535), r = a - k * 6.283185307179586476925;
            float sn, cs; sincos_d(r, sn, cs);
            TAB[t * 16 + f] = cs; TAB[t * 16 + 8 + f] = sn;
        }
    }

    for (int li = 0; li < 4; ++li) {
        const int lj = li >> 1; const bool nsa = (li & 1) == 0;
#ifdef DUP_W
        for (int rep_ = 0; rep_ < 2; ++rep_)
#endif
        {
            PTRS();
            ConvCtx c; c.scr = (LAS float*)(lds + wave * 16384); c.gw = gw; c.NGW = NGW; c.lane = lane; c.base = 0;
            if (nsa) {
                const float* win = FRESH_IN(2) + (size_t)lj * 1024 * 2608;
                conv_job(c, win, 2608, 1024, 1024, WA, 1024, 0);
                conv_job(c, win + 1024, 2608, 1024, 256, WA + (size_t)1024 * 1024, 1024, 0);
                conv_job(c, win + 1024 + 512, 2608, 1024, 256, WA + (size_t)1280 * 1024, 1024, 0);
                conv_job(c, win + 1024 + 1024, 2608, 1024, 256, WA + (size_t)1536 * 1024, 1024, 0);
                conv_job(c, win + 1024 + 256, 2608, 1024, 256, WA + (size_t)1792 * 1024, 1024, 0);
                conv_job(c, win + 2560, 2608, 1024, 48, WA + (size_t)2048 * 1024, 1024, 0);
                conv_job(c, win + 1024 + 768, 2608, 1024, 256, WVT, 1024, 0);
                conv_job(c, win + 1024 + 1280, 2608, 1024, 256, WVT + (size_t)256 * 1024, 1024, 0);
                conv_job(c, FRESH_IN(3) + (size_t)lj * 1024 * 1024, 1024, 1024, 1024, WO, 1024, 0);
                conv_job(c, FRESH_IN(5) + (size_t)lj * 2048 * 256, 256, 2048, 256, WC1, 2048, 0);
                conv_job(c, FRESH_IN(8) + (size_t)lj * 2048 * 256, 256, 2048, 256, WC1 + (size_t)256 * 2048, 2048, 0);
                conv_job(c, FRESH_IN(6) + (size_t)lj * 256 * 64, 64, 256, 64, WC2, 256, 0);
                conv_job(c, FRESH_IN(9) + (size_t)lj * 256 * 64, 64, 256, 64, WC2 + 64 * 256, 256, 0);
            } else {
                const float* win = FRESH_IN(10) + (size_t)lj * 1024 * 3072;
                conv_job(c, win, 3072, 1024, 2048, WA, 1024, 0);
                conv_job(c, win + 2048, 3072, 1024, 1024, WVT, 1024, 0);
                conv_job(c, FRESH_IN(11) + (size_t)lj * 1024 * 1024, 1024, 1024, 1024, WO, 1024, 0);
            }
            conv_job(c, FRESH_IN(12) + (size_t)li * 1024 * DFF, DFF, 1024, DFF, WGU, 1024, 1);
            conv_job(c, FRESH_IN(13) + (size_t)li * 1024 * DFF, DFF, 1024, DFF, WGU + (size_t)128 * 1024, 1024, 1);
            conv_job(c, FRESH_IN(14) + (size_t)li * DFF * 1024, 1024, DFF, 1024, WD, DFF, 0);
            if (nsa) {
                for (int it = gw; it < 128; it += NGW) {
                    const int kv = it >> 6, c4 = (it & 63) * 4;
                    const float* pe = FRESH_IN(kv ? 7 : 4) + (size_t)lj * 2048;
                    const float* w1 = FRESH_IN(kv ? 8 : 5) + (size_t)lj * 2048 * 256;
                    f32x4 s = {0.f, 0.f, 0.f, 0.f};
                    for (int r = lane; r < 2048; r += 64) { const f32x4 wv = *(const f32x4*)(w1 + (size_t)r * 256 + c4); s = s + wv * pe[r]; }
                    s[0] = wave_sum(s[0]); s[1] = wave_sum(s[1]); s[2] = wave_sum(s[2]); s[3] = wave_sum(s[3]);
                    if (lane == 0) *(f32x4*)(BIAS + kv * 256 + c4) = s;
                }
                if (bx == 0) { u32x4* z = (u32x4*)(KVC + (size_t)8 * S * 64); unsigned z0 = 0u; asm volatile("" : "+v"(z0)); if (tid < 256) z[tid] = (u32x4){z0, z0, z0, z0}; }
            }
        }
        GRID_SYNC();
        PH(8);
        if (nsa) {
            {
                PTRS();
                pg8::Gemm g{XB, WA, S, 2304, 1024, 1024}; pg8::StaticOrder so; so.init(S, 2304, G, bx);
                EpiNsaA E{Qb, KVC, KSEL, KWIN, GATES, TAB};
                pg8::gemm_phase<EpiNsaA, pg8::StaticOrder, PG8_ALIGN, PG8_SP2>(lds, g, so, E, tid);
            }
            {
                PTRS();
                pg8::Gemm g{WVT, XB, 512, S, 1024, 1024}; pg8::StaticOrder so; so.init(512, S, G, bx);
                EpiVfrag E{VSELT};
                pg8::gemm_phase<EpiVfrag, pg8::StaticOrder, PG8_ALIGN, PG8_SP2>(lds, g, so, E, tid);
            }
            GRID_SYNC();
            PH(9);
            {
                PTRS();
                pg8::Gemm g{KVC, WC1, 8192, 512, 2048, 1024}; CmpOrder so{G, bx};
                EpiCmp1 E{HC, BIAS};
                pg8::gemm_phase<EpiCmp1, CmpOrder, PG8_ALIGN, PG8_SP2>(lds, g, so, E, tid);
            }
            GRID_SYNC();
            PH(10);
            { PTRS();
            for (int it = gw; it < 512; it += NGW) {
                const int fr = lane & 15, kg = lane >> 4;
                const int r0 = it * 16, kv = r0 >> 12, gg = (r0 >> 10) & 3, n = (r0 & 1023) + fr;
                const bf16* hp = HC + (size_t)(r0 + fr) * 256 + 8 * kg;
                const bf16* wp = WC2 + (size_t)(kv * 64 + fr) * 256 + 8 * kg;
                f32x4 C[4] = {{0.f, 0.f, 0.f, 0.f}, {0.f, 0.f, 0.f, 0.f}, {0.f, 0.f, 0.f, 0.f}, {0.f, 0.f, 0.f, 0.f}};
#pragma unroll
                for (int ks = 0; ks < 8; ++ks) {
                    const bf16x8 b = ldg8(hp + 32 * ks);
#pragma unroll
                    for (int dt = 0; dt < 4; ++dt) C[dt] = MFMA16(ldg8(wp + (size_t)(16 * dt) * 256 + 32 * ks), b, C[dt]);
                }
                const int kap = n & 31;
                if (kv == 0) {
#pragma unroll
                    for (int dt = 0; dt < 4; ++dt) { u32x2 wv; wv.x = cvtpk(C[dt][0], C[dt][1]); wv.y = cvtpk(C[dt][2], C[dt][3]);
                        const int dim = 16 * dt + 4 * kg, lanef = ((dim & 31) >> 3) * 16 + 4 * (kap >> 3) + (kap & 3);
                        *(u32x2*)(KC + (size_t)gg * 65536 + ((size_t)(((n >> 5) * 2 + ((kap >> 2) & 1)) * 2 + (dim >> 5))) * 512 + lanef * 8 + (dim & 7)) = wv; }
                } else {
#pragma unroll
                    for (int dt = 0; dt < 4; ++dt)
#pragma unroll
                        for (int i = 0; i < 4; ++i) { const int dim = 16 * dt + 4 * kg + i;
                            VCT[(size_t)gg * 65536 + ((size_t)((n >> 5) * 4 + dt)) * 512 + ((kap >> 3) * 16 + (dim & 15)) * 8 + (kap & 7)] = (bf16)(cvtpk(C[dt][i], 0.f) & 0xffffu); }
                }
            }
            }
            GRID_SYNC();
            PH(10);
            {
                PTRS();
                NsaT A{Qb, KSEL, KWIN, VSELT, VSELT + (size_t)256 * S, KC, VCT, GATES, Ob, (f32x4*)(ws + 192 * MiB), (unsigned*)(ws + 65536)};
                for (int it = bx; it < 512; it += G) {
                    const int half = it >> 8, bb = it & 255, tb = bb >> 2, g = bb & 3;
                    const int T = half ? 127 - tb : tb;
                    nsa_unit(A, lds, T, g, wave, lane);
#ifdef DUP_NSA
                    nsa_unit(A, lds, T, g, wave, lane);
#endif
                }
            }
            GRID_SYNC();
            PH(11);
        } else {
            {
                PTRS();
                pg8::Gemm g{XB, WA, S, 2048, 1024, 1024}; pg8::StaticOrder so; so.init(S, 2048, G, bx);
                EpiMobaA E{Qb, MK, TAB};
                pg8::gemm_phase<EpiMobaA, pg8::StaticOrder, PG8_ALIGN, PG8_SP2>(lds, g, so, E, tid);
            }
            {
                PTRS();
                pg8::Gemm g{WVT, XB, 1024, S, 1024, 1024}; pg8::StaticOrder so; so.init(1024, S, G, bx);
                EpiVfrag E{MVT};
                pg8::gemm_phase<EpiVfrag, pg8::StaticOrder, PG8_ALIGN, PG8_SP2>(lds, g, so, E, tid);
            }
            GRID_SYNC();
            PH(9);
            { PTRS();
            for (int it = gw; it < 1024; it += NGW) {
                const int h = it >> 6, b = it & 63;
                const bf16* kp = MK + (size_t)h * S * 64 + (size_t)(b * 8) * 2048 + lane * 8;
#pragma unroll
                for (int sx = 0; sx < 2; ++sx) {
                    float acc[8] = {0.f, 0.f, 0.f, 0.f, 0.f, 0.f, 0.f, 0.f};
#pragma unroll 4
                    for (int r = 0; r < 16; ++r) { const bf16x8 v = ldg8(kp + (size_t)(r >> 1) * 2048 + ((r & 1) * 2 + sx) * 512);
#pragma unroll
                        for (int i = 0; i < 8; ++i) acc[i] += __uint_as_float(((unsigned)(unsigned short)v[i]) << 16); }
#pragma unroll
                    for (int i = 0; i < 8; ++i) { float a_ = acc[i]; a_ += dppf<0xB1>(a_); a_ += dppf<0x4E>(a_); a_ += dppf<0x141>(a_); a_ += dppf<0x140>(a_); acc[i] = a_ * (1.0f / 256.0f); }
                    if ((lane & 15) == 0) {
                        float hi[8], lo[8];
#pragma unroll
                        for (int i = 0; i < 8; ++i) { const unsigned hb = cvtpk(acc[i], 0.f) & 0xffffu; hi[i] = __uint_as_float(hb << 16); lo[i] = acc[i] - hi[i]; }
                        const int d0 = 32 * sx + 8 * (lane >> 4);
                        *(u32x4*)(KMH + ((size_t)h * 64 + b) * 64 + d0) = pack8(hi);
                        *(u32x4*)(KML + ((size_t)h * 64 + b) * 64 + d0) = pack8(lo);
                    }
                }
            }
            }
            GRID_SYNC();
            PH(10);
            {
                PTRS();
                MobaT A{Qb, MK, MVT, KMH, KML, Ob, (unsigned*)(ws + 65536)};
                for (int it = bx; it < 1024; it += G) {
                    const int kq = it >> 8, bb = it & 255, xcd = bb & 7, jj = bb >> 3;
                    const int h = xcd + 8 * (kq >> 1), QB = (kq & 1) ? 63 - jj : jj;
                    moba_unit2(A, lds, h, QB, wave);
#ifdef DUP_MOBA
                    moba_unit2(A, lds, h, QB, wave);
#endif
                }
            }
            GRID_SYNC();
            PH(12);
        }
        {
            PTRS();
            pg8::Gemm g{Ob, WO, S, 1024, 1024, 1024}; pg8::StaticOrder so; so.init(S, 1024, G, bx);
            EpiResid E{X};
            pg8::gemm_phase<EpiResid, pg8::StaticOrder, PG8_ALIGN, PG8_SP2>(lds, g, so, E, tid);
        }
        GRID_SYNC();
        PH(13);
        { PTRS(); const float* gg_ = FRESH_IN(15) + li * D; const float* bb_ = FRESH_IN(16) + li * D;
          for (int r = gw; r < S; r += NGW) ln_row(X + (size_t)r * D, XB + (size_t)r * D, gg_, bb_, lane); }
        GRID_SYNC();
        PH(14);
        {
            PTRS();
            pg8::Gemm g{XB, WGU, S, 2 * DFF, 1024, 1024}; pg8::StaticOrder so; so.init(S, 2 * DFF, G, bx);
            EpiSwiglu E{HB};
            pg8::gemm_phase<EpiSwiglu, pg8::StaticOrder, PG8_ALIGN, PG8_SP2>(lds, g, so, E, tid);
#ifdef DUP_FFN1
            pg8::gemm_phase<EpiSwiglu, pg8::StaticOrder, PG8_ALIGN, PG8_SP2>(lds, g, so, E, tid);
#endif
        }
        GRID_SYNC();
        PH(15);
        {
            PTRS();
            pg8::Gemm g{HB, WD, S, 1024, DFF, DFF}; pg8::StaticOrder so; so.init(S, 1024, G, bx);
            EpiResid E{X};
            pg8::gemm_phase<EpiResid, pg8::StaticOrder, PG8_ALIGN, PG8_SP2>(lds, g, so, E, tid);
        }
        GRID_SYNC();
        PH(16);
        { PTRS(); const float* gg_ = FRESH_IN(17) + li * D; const float* bb_ = FRESH_IN(18) + li * D;
          for (int r = gw; r < S; r += NGW) ln_row(X + (size_t)r * D, XB + (size_t)r * D, gg_, bb_, lane); }
        GRID_SYNC();
        PH(14);
    }
#ifdef TIMING
    {
        unsigned* tim = (unsigned*)(args.ws + 65536);
        const int tidf = wave_s * 64 + lane_id();
        if (blockIdx.x == 0 && tidf == 0) { __hip_atomic_store(tim + 17, ((unsigned)__builtin_amdgcn_s_memrealtime() - tk_begin), __ATOMIC_RELAXED, __HIP_MEMORY_SCOPE_AGENT); }
        GRID_SYNC();
        const float tot = (float)__hip_atomic_load(tim + 17, __ATOMIC_RELAXED, __HIP_MEMORY_SCOPE_AGENT);
        const float pa = 100.f * (float)__hip_atomic_load(tim + PROBE_A, __ATOMIC_RELAXED, __HIP_MEMORY_SCOPE_AGENT) / tot;
        const float pb = 100.f * (float)__hip_atomic_load(tim + PROBE_B, __ATOMIC_RELAXED, __HIP_MEMORY_SCOPE_AGENT) / tot;
        float* Xo = args.out;
        for (size_t i = (size_t)(1u << 20) + (size_t)blockIdx.x * NTHR + tidf; i < (size_t)(1u << 20) + (size_t)(1u << 23); i += (size_t)gridDim.x * NTHR) Xo[i] += pb;
        if (blockIdx.x == 0 && tidf == 0) Xo[0] = 100.f * pa;
    }
#endif
}

extern "C" void kernel_launch(void* const* d_in, const int* in_sizes, int n_in, void* d_out, int out_size, void* d_ws, size_t ws_size, hipStream_t stream) {
    static int grid = 0;
    if (grid == 0) {
        int dev = 0, cus = 0, per_cu = 0;
        hipGetDevice(&dev);
        hipDeviceGetAttribute(&cus, hipDeviceAttributeMultiprocessorCount, dev);
        hipFuncSetAttribute((const void*)trunk_fwd, hipFuncAttributeMaxDynamicSharedMemorySize, LDS_BYTES);
        hipOccupancyMaxActiveBlocksPerMultiprocessor(&per_cu, (const void*)trunk_fwd, NTHR, LDS_BYTES);
        if (per_cu < 1) { fprintf(stderr, "kernel_launch: occupancy query says %d blocks per CU\n", per_cu); per_cu = 1; }
        if (per_cu > 1) per_cu = 1;
        grid = cus * per_cu;
        (void)hipGetLastError();
    }
    (void)hipMemsetAsync(d_ws, 0, 1u << 20, stream);
    Args a{};
    for (int i = 0; i < 19; ++i) a.in[i] = (const float*)d_in[i];
    a.pos = (const int*)d_in[1]; a.out = (float*)d_out; a.ws = (unsigned char*)d_ws;
    void* kargs[] = {&a};
    hipError_t e = hipLaunchCooperativeKernel((const void*)trunk_fwd, dim3(grid), dim3(NTHR), kargs, LDS_BYTES, stream);
    if (e != hipSuccess) fprintf(stderr, "cooperative launch failed: %s (grid %d)\n", hipGetErrorString(e), grid);
}
```
